# Optimizing an MI355X kernel written in HIP

```python
import jax, jax.numpy as jnp
from jax import lax
import numpy as np

D_MODEL = 1024
BATCH = 32
SEQ = 2048
DEPTH = 1
DEC_BATCH = 8
DEC_SEQ = 16
PAST_LEN = 2048

CHUNK = 64
HG_HEADS = 4
HG_DK = 128
HG_DV = 128
HG_WIDTH = HG_HEADS * HG_DV
ATTN_HEADS = 8
ATTN_KV_HEADS = 2
ATTN_HEAD_DIM = 64
ATTN_GROUP = ATTN_HEADS // ATTN_KV_HEADS
ATTN_WIDTH = ATTN_HEADS * ATTN_HEAD_DIM
MIX_WIDTH = HG_WIDTH + ATTN_WIDTH
WINDOW = 128
BAND = WINDOW // CHUNK + 1
MEM_TOKENS = 256
MEM_HEADS = 4
MEM_HEAD_DIM = D_MODEL // MEM_HEADS
D_FF = -(-8 * D_MODEL // (3 * 256)) * 256
IN_SPLITS = (HG_HEADS * HG_DK, HG_HEADS * HG_DK, HG_WIDTH, HG_WIDTH,
             ATTN_WIDTH, ATTN_KV_HEADS * ATTN_HEAD_DIM, ATTN_KV_HEADS * ATTN_HEAD_DIM)
IN_COLS = (2 * HG_HEADS * HG_DK + 2 * HG_WIDTH + ATTN_WIDTH
           + 2 * ATTN_KV_HEADS * ATTN_HEAD_DIM)
ALPHA = (2.0 * DEPTH) ** 0.25
BETA = (8.0 * DEPTH) ** -0.25
NEG = -1e30

kernel_name = "hymba_hgrn2_swa_sink_alibi_deepnorm_stream"


def layer_norm(x, g, b, eps=1e-5):
    xf = x.astype(jnp.float32)
    mu = xf.mean(-1, keepdims=True)
    var = jnp.square(xf - mu).mean(-1, keepdims=True)
    return ((xf - mu) * lax.rsqrt(var + eps) * g.astype(jnp.float32)
            + b.astype(jnp.float32)).astype(x.dtype)


def rms_norm(x, g, eps=1e-6):
    xf = x.astype(jnp.float32)
    return xf * lax.rsqrt(jnp.mean(jnp.square(xf), -1, keepdims=True) + eps) * g.astype(jnp.float32)


def split_in(z):
    return jnp.split(z, list(np.cumsum(IN_SPLITS)[:-1]), axis=-1)


def gla_chunkwise(q, k, v, logf, S0, L):
    B, T, H, dk = q.shape
    dv = v.shape[-1]
    N = T // L
    blk = lambda a: jnp.moveaxis(a.reshape(B, N, L, H, a.shape[-1]), 1, 0)
    qr, kr, vr = blk(q), blk(k), blk(v)
    Gr = jnp.cumsum(blk(logf), axis=2)
    mask = jnp.tril(jnp.ones((L, L), bool))

    def step(S, inp):
        qc, kc, vc, Gc = inp
        qg = qc * jnp.exp(Gc)
        kg = kc * jnp.exp(-Gc)
        A = jnp.where(mask, jnp.einsum('blhk,bshk->bhls', qg, kg), 0.0)
        o = jnp.einsum('bhls,bshv->blhv', A, vc) + jnp.einsum('blhk,bhkv->blhv', qg, S)
        GL = Gc[:, -1]
        kdec = kc * jnp.exp(GL[:, None] - Gc)
        S = jnp.exp(GL)[..., None] * S + jnp.einsum('bshk,bshv->bhkv', kdec, vc)
        return S, o

    S, o = lax.scan(step, S0, (qr, kr, vr, Gr))
    return jnp.moveaxis(o, 0, 1).reshape(B, T, H, dv), S


def hgrn_mixer(hq, hf, hi, hg, lb, g_norm, S0):
    B, T, _ = hq.shape
    hshape = (B, T, HG_HEADS, HG_DK)
    f = lb + (1.0 - lb) * jax.nn.sigmoid(hf.astype(jnp.float32))
    q = jax.nn.silu(hq.astype(jnp.float32)).reshape(hshape)
    k = (1.0 - f).reshape(hshape)
    logf = jnp.log(f).reshape(hshape)
    v = hi.astype(jnp.float32).reshape(B, T, HG_HEADS, HG_DV)
    o, S = gla_chunkwise(q, k, v, logf, S0.astype(jnp.float32), min(CHUNK, T))
    o = rms_norm(o, g_norm) * jax.nn.silu(hg.astype(jnp.float32)).reshape(B, T, HG_HEADS, HG_DV)
    return o.reshape(B, T, HG_WIDTH).astype(hq.dtype), S


def alibi_bias(qpos, kpos):
    slopes = jnp.asarray(2.0 ** (-8.0 * np.arange(1, ATTN_HEADS + 1) / ATTN_HEADS), jnp.float32)
    dist = jnp.abs(qpos[:, None] - kpos[None, :]).astype(jnp.float32)
    return -slopes.reshape(ATTN_KV_HEADS, ATTN_GROUP, 1, 1) * dist


def sink_attention(q, k, v, bias, valid, sinks):
    s = jnp.einsum('...qhgd,...khd->...hgqk', q, k).astype(jnp.float32) * ATTN_HEAD_DIM ** -0.5 + bias
    if valid is not None:
        s = jnp.where(valid, s, NEG)
    sink = jnp.broadcast_to(sinks.astype(jnp.float32).reshape(ATTN_KV_HEADS, ATTN_GROUP, 1, 1),
                            s.shape[:-1] + (1,))
    p = jax.nn.softmax(jnp.concatenate([s, sink], axis=-1), axis=-1)[..., :-1]
    return jnp.einsum('...hgqk,...khd->...qhgd', p.astype(v.dtype), v)


def band_blocks(a):
    B, T = a.shape[:2]
    N = T // CHUNK
    ac = a.reshape(B, N, CHUNK, ATTN_KV_HEADS, ATTN_HEAD_DIM)
    ap = jnp.concatenate([jnp.zeros((B, BAND - 1) + ac.shape[2:], a.dtype), ac], axis=1)
    blocks = jnp.stack([ap[:, i:i + N] for i in range(BAND)], axis=2)
    return blocks.reshape(B, N, BAND * CHUNK, ATTN_KV_HEADS, ATTN_HEAD_DIM)


def swa_prompt(aq, ak, av, sinks):
    B, T, _ = aq.shape
    N = T // CHUNK
    q = aq.reshape(B, N, CHUNK, ATTN_KV_HEADS, ATTN_GROUP, ATTN_HEAD_DIM)
    k_rows = ak.reshape(B, T, ATTN_KV_HEADS, ATTN_HEAD_DIM)
    v_rows = av.reshape(B, T, ATTN_KV_HEADS, ATTN_HEAD_DIM)
    kb, vb = band_blocks(k_rows), band_blocks(v_rows)
    bias = alibi_bias(jnp.arange(CHUNK) + (BAND - 1) * CHUNK, jnp.arange(BAND * CHUNK))
    key_chunk = jnp.arange(N)[:, None] - (BAND - 1) + jnp.arange(BAND * CHUNK)[None, :] // CHUNK
    valid = (key_chunk >= 0)[:, None, None, None, :]
    o = sink_attention(q, kb, vb, bias, valid, sinks)
    W = min(WINDOW, T)
    return o.reshape(B, T, ATTN_WIDTH), k_rows[:, T - W:], v_rows[:, T - W:]


def swa_sample(aq, ak, av, k_cache, v_cache, sinks):
    B, T, _ = aq.shape
    W = k_cache.shape[1]
    q = aq.reshape(B, T, ATTN_KV_HEADS, ATTN_GROUP, ATTN_HEAD_DIM)
    k_new = ak.reshape(B, T, ATTN_KV_HEADS, ATTN_HEAD_DIM)
    v_new = av.reshape(B, T, ATTN_KV_HEADS, ATTN_HEAD_DIM)
    k = jnp.concatenate([k_cache.astype(k_new.dtype), k_new], axis=1)
    v = jnp.concatenate([v_cache.astype(v_new.dtype), v_new], axis=1)
    bias = alibi_bias(W + jnp.arange(T), jnp.arange(W + T))
    o = sink_attention(q, k, v, bias, None, sinks)
    return o.reshape(B, T, ATTN_WIDTH), k_new, v_new


def mem_kv(mem, w_mem_kv):
    B, M, _ = mem.shape
    mk, mv = jnp.split(mem @ w_mem_kv, 2, axis=-1)
    return (mk.reshape(B, M, MEM_HEADS, MEM_HEAD_DIM), mv.reshape(B, M, MEM_HEADS, MEM_HEAD_DIM))


def mem_attention(x, mk, mv, w_q, w_o):
    B, T, _ = x.shape
    q = (x @ w_q).reshape(B, T, MEM_HEADS, MEM_HEAD_DIM)
    s = jnp.einsum('bthd,bmhd->bhtm', q, mk.astype(q.dtype)).astype(jnp.float32) * MEM_HEAD_DIM ** -0.5
    p = jax.nn.softmax(s, axis=-1)
    o = jnp.einsum('bhtm,bmhd->bthd', p.astype(x.dtype), mv.astype(x.dtype)).reshape(B, T, D_MODEL)
    return o @ w_o


def swiglu(x, w_in, w_out):
    g, u = jnp.split(x @ w_in, 2, axis=-1)
    return (jax.nn.silu(g) * u) @ w_out


def post_blocks(x, mix, mk, mv, w_mem_q, w_mem_o, w_ffn_in, w_ffn_out, ln_g, ln_b):
    x = layer_norm(ALPHA * x + mix, ln_g[0], ln_b[0])
    x = layer_norm(ALPHA * x + mem_attention(x, mk, mv, w_mem_q, w_mem_o), ln_g[1], ln_b[1])
    x = layer_norm(ALPHA * x + swiglu(x, w_ffn_in, w_ffn_out), ln_g[2], ln_b[2])
    return x


def setup_inputs(seed: int = 0) -> dict:
    key = jax.random.key(seed)
    ks = jax.random.split(key, 20)
    nrm = lambda k, shape, scale: jax.random.normal(k, shape, jnp.float32) * scale
    W = min(WINDOW, PAST_LEN)
    return {
        "x_prompt": nrm(ks[0], (BATCH, SEQ, D_MODEL), 1.0),
        "x_sample": nrm(ks[1], (DEC_BATCH, DEC_SEQ, D_MODEL), 1.0),
        "cache_swa_k": nrm(ks[2], (DEPTH, DEC_BATCH, W, ATTN_KV_HEADS, ATTN_HEAD_DIM), 1.0),
        "cache_swa_v": nrm(ks[3], (DEPTH, DEC_BATCH, W, ATTN_KV_HEADS, ATTN_HEAD_DIM), 1.0),
        "state_hgrn": nrm(ks[4], (DEPTH, DEC_BATCH, HG_HEADS, HG_DK, HG_DV), 0.5),
        "cache_mem_k": nrm(ks[5], (DEPTH, DEC_BATCH, MEM_TOKENS, MEM_HEADS, MEM_HEAD_DIM), 1.0),
        "cache_mem_v": nrm(ks[6], (DEPTH, DEC_BATCH, MEM_TOKENS, MEM_HEADS, MEM_HEAD_DIM), 1.0),
        "mem_prompt": nrm(ks[7], (BATCH, MEM_TOKENS, D_MODEL), 1.0),
        "w_in": nrm(ks[8], (DEPTH, D_MODEL, IN_COLS), D_MODEL ** -0.5),
        "hgrn_lb_logits": 1.0 + nrm(ks[9], (DEPTH + 1, HG_HEADS * HG_DK), 0.1),
        "hgrn_norm_g": 1.0 + nrm(ks[10], (DEPTH, HG_DV), 0.02),
        "attn_sinks": nrm(ks[11], (DEPTH, ATTN_HEADS), 0.5),
        "w_out": nrm(ks[12], (DEPTH, MIX_WIDTH, D_MODEL), MIX_WIDTH ** -0.5 * BETA),
        "w_mem_q": nrm(ks[13], (DEPTH, D_MODEL, D_MODEL), D_MODEL ** -0.5),
        "w_mem_kv": nrm(ks[14], (DEPTH, D_MODEL, 2 * D_MODEL), D_MODEL ** -0.5),
        "w_mem_o": nrm(ks[15], (DEPTH, D_MODEL, D_MODEL), D_MODEL ** -0.5 * BETA),
        "w_ffn_in": nrm(ks[16], (DEPTH, D_MODEL, 2 * D_FF), D_MODEL ** -0.5),
        "w_ffn_out": nrm(ks[17], (DEPTH, D_FF, D_MODEL), D_FF ** -0.5 * BETA),
        "ln_g": 1.0 + nrm(ks[18], (DEPTH, 3, D_MODEL), 0.02),
        "ln_b": nrm(ks[19], (DEPTH, 3, D_MODEL), 0.02),
    }


def reference(x_prompt, x_sample, cache_swa_k, cache_swa_v, state_hgrn, cache_mem_k, cache_mem_v,
              mem_prompt, w_in, hgrn_lb_logits, hgrn_norm_g, attn_sinks, w_out, w_mem_q, w_mem_kv,
              w_mem_o, w_ffn_in, w_ffn_out, ln_g, ln_b):
    lb_all = jnp.cumsum(jax.nn.softmax(hgrn_lb_logits.astype(jnp.float32), axis=0), axis=0)
    yp, ys = x_prompt, x_sample
    kp_l, vp_l, sp_l, mkp_l, mvp_l, ks_l, vs_l, ss_l = [], [], [], [], [], [], [], []
    for l in range(DEPTH):
        hq, hf, hi, hg, aq, ak, av = split_in(yp @ w_in[l])
        S0 = jnp.zeros((yp.shape[0], HG_HEADS, HG_DK, HG_DV), jnp.float32)
        o_h, S_p = hgrn_mixer(hq, hf, hi, hg, lb_all[l], hgrn_norm_g[l], S0)
        o_a, k_p, v_p = swa_prompt(aq, ak, av, attn_sinks[l])
        mix = jnp.concatenate([o_h, o_a], axis=-1) @ w_out[l]
        mk_p, mv_p = mem_kv(mem_prompt, w_mem_kv[l])
        yp = post_blocks(yp, mix, mk_p, mv_p, w_mem_q[l], w_mem_o[l], w_ffn_in[l], w_ffn_out[l],
                         ln_g[l], ln_b[l])
        hq, hf, hi, hg, aq, ak, av = split_in(ys @ w_in[l])
        o_h, S_s = hgrn_mixer(hq, hf, hi, hg, lb_all[l], hgrn_norm_g[l], state_hgrn[l])
        o_a, k_s, v_s = swa_sample(aq, ak, av, cache_swa_k[l], cache_swa_v[l], attn_sinks[l])
        mix = jnp.concatenate([o_h, o_a], axis=-1) @ w_out[l]
        ys = post_blocks(ys, mix, cache_mem_k[l], cache_mem_v[l], w_mem_q[l], w_mem_o[l],
                         w_ffn_in[l], w_ffn_out[l], ln_g[l], ln_b[l])
        kp_l.append(k_p); vp_l.append(v_p); sp_l.append(S_p)
        mkp_l.append(mk_p); mvp_l.append(mv_p)
        ks_l.append(k_s); vs_l.append(v_s); ss_l.append(S_s)
    new_swa_k_prompt = jnp.stack(kp_l)
    new_swa_v_prompt = jnp.stack(vp_l)
    new_hgrn_state_prompt = jnp.stack(sp_l)
    new_mem_k_prompt = jnp.stack(mkp_l)
    new_mem_v_prompt = jnp.stack(mvp_l)
    new_swa_k_sample = jnp.stack(ks_l)
    new_swa_v_sample = jnp.stack(vs_l)
    new_hgrn_state_sample = jnp.stack(ss_l)
    return (yp, ys, new_swa_k_prompt, new_swa_v_prompt, new_hgrn_state_prompt, new_mem_k_prompt,
            new_mem_v_prompt, new_swa_k_sample, new_swa_v_sample, new_hgrn_state_sample)
```

```cpp
#include <hip/hip_runtime.h>
#include <hip/hip_cooperative_groups.h>
#include <cstdio>
#include <cstdint>
namespace cg = cooperative_groups;

constexpr int DM = 1024;
constexpr int NBATCH = 32, SEQ = 2048, MP = NBATCH * SEQ;
constexpr int SBATCH = 8, SSEQ = 16, MS = SBATCH * SSEQ;
constexpr int MT = MP + 256;
constexpr int INC = 2816, DFF = 2816, MEMT = 256;
constexpr int MEMROWS_P = NBATCH * MEMT, MEMROWS = MEMROWS_P + SBATCH * MEMT;
constexpr float ALPHA = 1.189207115002721f;
constexpr float LN_EPS = 1e-5f;
constexpr int ZC_HQ = 0, ZC_HF = 512, ZC_HI = 1024, ZC_HG = 1536, ZC_AQ = 2048, ZC_AK = 2560, ZC_AV = 2688;
constexpr size_t OFF_YP = 0, OFF_YS = OFF_YP + (size_t)MP * DM, OFF_KP = OFF_YS + (size_t)MS * DM, OFF_VP = OFF_KP + 32 * 128 * 128,
                 OFF_SP = OFF_VP + 32 * 128 * 128, OFF_MK = OFF_SP + 32 * 4 * 128 * 128, OFF_MV = OFF_MK + (size_t)MEMROWS_P * DM,
                 OFF_KS = OFF_MV + (size_t)MEMROWS_P * DM, OFF_VS = OFF_KS + MS * 128, OFF_SS = OFF_VS + MS * 128, OUT_TOTAL = OFF_SS + 8 * 4 * 128 * 128;
constexpr size_t WS_CTL = 0;
constexpr size_t WS_WIN = 65536;
constexpr size_t WS_WOUT = WS_WIN + (size_t)INC * DM * 2;
constexpr size_t WS_WQ = WS_WOUT + (size_t)DM * DM * 2;
constexpr size_t WS_WKV = WS_WQ + (size_t)DM * DM * 2;
constexpr size_t WS_WO = WS_WKV + (size_t)2 * DM * DM * 2;
constexpr size_t WS_WF1 = WS_WO + (size_t)DM * DM * 2;
constexpr size_t WS_WF2 = WS_WF1 + (size_t)2 * DFF * DM * 2;
constexpr size_t WS_XB = WS_WF2 + (size_t)DFF * DM * 2;
constexpr size_t WS_Z = WS_XB + (size_t)MT * DM * 2;
constexpr size_t WS_MIX = WS_Z + (size_t)MT * INC * 2;
constexpr size_t WS_XPRE = WS_MIX + (size_t)MT * DM * 2;
constexpr size_t WS_MEMB = WS_XPRE + (size_t)MT * DM * 2;
constexpr size_t WS_MKB = WS_MEMB + (size_t)MEMROWS_P * DM * 2;
constexpr size_t WS_MVB = WS_MKB + (size_t)MEMROWS * DM * 2;
constexpr size_t WS_XCH = WS_MVB + (size_t)MEMROWS * DM * 2;
constexpr size_t WS_CNT = WS_XCH + (size_t)3 * MP * 4 * 8;
constexpr int NBT = NBATCH + SBATCH;
constexpr size_t WS_WPT = WS_CNT + (size_t)3 * 256 * 256;
constexpr size_t WS_VPT = WS_WPT + (size_t)NBT * DM * DM * 2;
constexpr size_t WS_END = WS_VPT + (size_t)NBT * DM * DM * 2;
static_assert(WS_END <= (size_t)1073741824, "d_ws map exceeds the guaranteed 1 GiB");
namespace pg8 {
#define PG8_LAS __attribute__((address_space(3)))
typedef unsigned short bf16_t;
typedef short bf16x8 __attribute__((ext_vector_type(8)));
typedef float f32x4 __attribute__((ext_vector_type(4)));
typedef unsigned u32x4 __attribute__((ext_vector_type(4)));
constexpr int BM = 256, BK = 64, HALF = 128, HTB = HALF * BK * 2  , STAGE_BYTES = 8 * HTB, NXCD = 8, WGM = 8;

__host__ __device__ __forceinline__ int lds_byte(int r, int c) { const int st = (r >> 4) * 2 + (c >> 5), rr = r & 15, cc = c & 31, ob = rr * 64 + cc * 2; return st * 1024 + (ob ^ (((ob >> 9) & 1) << 5)); }
__host__ __device__ __forceinline__ void stage_rc(int b, int& R, int& C) { const int st = b / 1024, sb = b % 1024, swz = sb ^ (((sb >> 9) & 1) << 5); R = (st >> 1) * 16 + swz / 64; C = (st & 1) * 32 + (swz % 64) / 2; }
__host__ __device__ __forceinline__ int perm32(int rho) { const int n = rho >> 4, i = rho & 15; return 8 * (i >> 2) + 4 * n + (i & 3); }

struct Unit { int pm, pn; };
struct Gemm { const bf16_t* A; const bf16_t* Bt; int M, N, K, lda, ldb, mode;
    __device__ __forceinline__ size_t aoff(const Unit& u) const {
        if (mode == 1) return ((size_t)(u.pm >> 2) * 256 * lda + (size_t)(u.pm & 3) * 256) * 2;
        if (mode == 2) return ((size_t)(u.pm & 3) * 256 * lda + (size_t)u.pn * 256) * 2;
        return (size_t)u.pm * 256 * lda * 2; }
    __device__ __forceinline__ size_t boff(const Unit& u) const {
        if (mode == 1) return ((size_t)u.pn * 256 * ldb + (size_t)(u.pm & 3) * 256) * 2;
        if (mode == 2) return ((size_t)(u.pm >> 2) * 256 * ldb + (size_t)u.pn * 256) * 2;
        if (mode == 3) return ((size_t)(u.pm >> 3) * 1024 + (size_t)u.pn * 256) * ldb * 2;
        return (size_t)u.pn * 256 * ldb * 2; }
};

struct StaticOrder {
    int nM, nN, nwg, G, c;
    __host__ __device__ void init(int M, int N, int G_, int c_) { nM = M / BM; nN = N / BM; nwg = nM * nN; G = G_; c = c_; }
    __host__ __device__ bool next(int i, Unit& u) const {
        const long L = (long)i * G + c; if (L >= nwg) return false;
        int wgid = (int)L; { const int q = nwg / NXCD, r = nwg % NXCD, xcd = wgid % NXCD, off = wgid / NXCD; wgid = (xcd < r ? xcd * (q + 1) : r * (q + 1) + (xcd - r) * q) + off; }
        const int nig = WGM * nN, gid = wgid / nig, fm = gid * WGM, gsz = (nM - fm) < WGM ? (nM - fm) : WGM;
        u.pm = fm + ((wgid % nig) % gsz); u.pn = (wgid % nig) / gsz; return true;
    }
    __device__ __forceinline__ void a_ready(const Unit&) const {}
    __device__ __forceinline__ void done(const Unit&) const {}
};

typedef float f32x2 __attribute__((ext_vector_type(2)));
typedef __bf16 bf16x2_t __attribute__((ext_vector_type(2)));
__device__ __forceinline__ unsigned cvt_pk_bf16(float lo, float hi) { f32x2 v = {lo, hi}; bf16x2_t b = __builtin_convertvector(v, bf16x2_t); return __builtin_bit_cast(unsigned, b); }
typedef unsigned u32x2 __attribute__((ext_vector_type(2)));
__device__ __forceinline__ float silu_f(float g) { return g * __builtin_amdgcn_rcpf(1.0f + __expf(-g)); }
struct EpiZ {
    static constexpr bool PERM = true, AFTER_DRAIN = false;
    bf16_t* Z; float* out;
    __device__ __forceinline__ void operator()(const f32x4 (&acc)[2][2][4][2], const Unit& u, int wr, int wc, int fr, int fq) const {
        const int row0 = u.pm * BM + wr * 64 + fr, col0 = u.pn * BM + wc * 32 + 8 * fq;
        const bool kvt = (u.pn == 10), act = (u.pn < 2 || u.pn == 6 || u.pn == 7);
#pragma unroll
        for (int ai = 0; ai < 2; ++ai)
#pragma unroll
            for (int m = 0; m < 4; ++m) {
                const int row = row0 + ai * HALF + m * 16;
                bf16_t* rowp = Z + (size_t)row * INC + col0;
                long kvoff = -1, vdelta = 0;
                if (kvt) {
                    if (row < MP) { const int t = row & (SEQ - 1); if (t >= SEQ - 128) { kvoff = (long)OFF_KP + ((long)(row >> 11) * 128 + (t - (SEQ - 128))) * 128; vdelta = (long)(OFF_VP - OFF_KP); } }
                    else if (row < MP + MS) { kvoff = (long)OFF_KS + (long)(row - MP) * 128; vdelta = (long)(OFF_VS - OFF_KS); }
                }
#pragma unroll
                for (int bj = 0; bj < 2; ++bj) {
                    f32x4 v0 = acc[ai][bj][m][0], v1 = acc[ai][bj][m][1];
                    if (act) {
#pragma unroll
                        for (int e = 0; e < 4; ++e) { v0[e] = silu_f(v0[e]); v1[e] = silu_f(v1[e]); } }
                    u32x4 w; w.x = cvt_pk_bf16(v0[0], v0[1]); w.y = cvt_pk_bf16(v0[2], v0[3]); w.z = cvt_pk_bf16(v1[0], v1[1]); w.w = cvt_pk_bf16(v1[2], v1[3]);
                    __builtin_nontemporal_store(w, (u32x4*)(rowp + bj * HALF));
                    if (kvoff >= 0) { float* d = out + kvoff + (bj ? vdelta : 0) + wc * 32 + 8 * fq; *(f32x4*)d = v0; *(f32x4*)(d + 4) = v1; }
                }
            }
    }
};
struct EpiKV {
    static constexpr bool PERM = true, AFTER_DRAIN = false;
    bf16_t* MKB; bf16_t* MVB; float* out;
    __device__ __forceinline__ void operator()(const f32x4 (&acc)[2][2][4][2], const Unit& u, int wr, int wc, int fr, int fq) const {
        const int row0 = u.pm * BM + wr * 64 + fr; const bool isv = (u.pn >= 4);
        const int col0 = (u.pn & 3) * BM + wc * 32 + 8 * fq;
        bf16_t* B = isv ? MVB : MKB; float* O = out + (isv ? OFF_MV : OFF_MK);
#pragma unroll
        for (int ai = 0; ai < 2; ++ai)
#pragma unroll
            for (int m = 0; m < 4; ++m) {
                const size_t off = (size_t)(row0 + ai * HALF + m * 16) * DM + col0;
#pragma unroll
                for (int bj = 0; bj < 2; ++bj) {
                    const f32x4 v0 = acc[ai][bj][m][0], v1 = acc[ai][bj][m][1];
                    u32x4 w; w.x = cvt_pk_bf16(v0[0], v0[1]); w.y = cvt_pk_bf16(v0[2], v0[3]); w.z = cvt_pk_bf16(v1[0], v1[1]); w.w = cvt_pk_bf16(v1[2], v1[3]);
                    *(u32x4*)(B + off + bj * HALF) = w;
                    *(f32x4*)(O + off + bj * HALF) = v0; *(f32x4*)(O + off + bj * HALF + 4) = v1;
                }
            }
    }
};
struct EpiRes {
    static constexpr bool PERM = true, AFTER_DRAIN = false;
    bf16_t* XPRE; const bf16_t* XB; const float* xp; const float* xs; int mode;
    __device__ __forceinline__ void operator()(const f32x4 (&acc)[2][2][4][2], const Unit& u, int wr, int wc, int fr, int fq) const {
        const int row0 = u.pm * BM + wr * 64 + fr, col0 = u.pn * BM + wc * 32 + 8 * fq;
#pragma unroll
        for (int ai = 0; ai < 2; ++ai)
#pragma unroll
            for (int m = 0; m < 4; ++m) {
                const int row = row0 + ai * HALF + m * 16;
                const float* rf = nullptr;
                if (mode == 0) { if (row < MP) rf = xp + (size_t)row * DM + col0; else if (row < MP + MS) rf = xs + (size_t)(row - MP) * DM + col0; }
#pragma unroll
                for (int bj = 0; bj < 2; ++bj) {
                    f32x4 r0 = (f32x4){0.f, 0.f, 0.f, 0.f}, r1 = r0;
                    if (mode == 0) { if (rf) { r0 = *(const f32x4*)(rf + bj * HALF); r1 = *(const f32x4*)(rf + bj * HALF + 4); } }
                    else { const u32x4 w = *(const u32x4*)(XB + (size_t)row * DM + col0 + bj * HALF);
                        r0 = (f32x4){__uint_as_float(w.x << 16), __uint_as_float(w.x & 0xffff0000u), __uint_as_float(w.y << 16), __uint_as_float(w.y & 0xffff0000u)};
                        r1 = (f32x4){__uint_as_float(w.z << 16), __uint_as_float(w.z & 0xffff0000u), __uint_as_float(w.w << 16), __uint_as_float(w.w & 0xffff0000u)}; }
                    const f32x4 v0 = r0 * ALPHA + acc[ai][bj][m][0], v1 = r1 * ALPHA + acc[ai][bj][m][1];
                    u32x4 o; o.x = cvt_pk_bf16(v0[0], v0[1]); o.y = cvt_pk_bf16(v0[2], v0[3]); o.z = cvt_pk_bf16(v1[0], v1[1]); o.w = cvt_pk_bf16(v1[2], v1[3]);
                    *(u32x4*)(XPRE + (size_t)row * DM + col0 + bj * HALF) = o;
                }
            }
    }
};
struct EpiQ {
    static constexpr bool PERM = true, AFTER_DRAIN = false;
    bf16_t* O; float scale; int nt;
    __device__ __forceinline__ void operator()(const f32x4 (&acc)[2][2][4][2], const Unit& u, int wr, int wc, int fr, int fq) const {
        const int row0 = u.pm * BM + wr * 64 + fr, col0 = u.pn * BM + wc * 32 + 8 * fq;
#pragma unroll
        for (int ai = 0; ai < 2; ++ai)
#pragma unroll
            for (int m = 0; m < 4; ++m) {
                bf16_t* rowp = O + (size_t)(row0 + ai * HALF + m * 16) * DM + col0;
#pragma unroll
                for (int bj = 0; bj < 2; ++bj) {
                    const f32x4 v0 = acc[ai][bj][m][0] * scale, v1 = acc[ai][bj][m][1] * scale;
                    u32x4 w; w.x = cvt_pk_bf16(v0[0], v0[1]); w.y = cvt_pk_bf16(v0[2], v0[3]); w.z = cvt_pk_bf16(v1[0], v1[1]); w.w = cvt_pk_bf16(v1[2], v1[3]);
                    if (nt) __builtin_nontemporal_store(w, (u32x4*)(rowp + bj * HALF)); else *(u32x4*)(rowp + bj * HALF) = w;
                }
            }
    }
};
struct EpiSwiglu {
    static constexpr bool PERM = true, AFTER_DRAIN = false;
    bf16_t* H;
    __device__ __forceinline__ void operator()(const f32x4 (&acc)[2][2][4][2], const Unit& u, int wr, int wc, int fr, int fq) const {
        const int row0 = u.pm * BM + wr * 64 + fr, col0 = u.pn * HALF + wc * 32 + 8 * fq;
#pragma unroll
        for (int ai = 0; ai < 2; ++ai)
#pragma unroll
            for (int m = 0; m < 4; ++m) {
                const f32x4 g0 = acc[ai][0][m][0], g1 = acc[ai][0][m][1], u0 = acc[ai][1][m][0], u1 = acc[ai][1][m][1];
                u32x4 w;
                w.x = cvt_pk_bf16(silu_f(g0[0]) * u0[0], silu_f(g0[1]) * u0[1]); w.y = cvt_pk_bf16(silu_f(g0[2]) * u0[2], silu_f(g0[3]) * u0[3]);
                w.z = cvt_pk_bf16(silu_f(g1[0]) * u1[0], silu_f(g1[1]) * u1[1]); w.w = cvt_pk_bf16(silu_f(g1[2]) * u1[2], silu_f(g1[3]) * u1[3]);
                __builtin_nontemporal_store(w, (u32x4*)(H + (size_t)(row0 + ai * HALF + m * 16) * DFF + col0));
            }
    }
};
struct EpiResLN {
    static constexpr bool PERM = true, AFTER_DRAIN = false;
    const bf16_t* XBres; const float* xp; bf16_t* XBout; float* yout; const float* g; const float* b;
    unsigned long long* xbuf; PG8_LAS unsigned char* xl;
    __device__ __forceinline__ void operator()(f32x4 (&acc)[2][2][4][2], const Unit& u, int wr, int wc, int fr, int fq) const {
        const int wid = wr * 4 + wc, lane = fq * 16 + fr, tid = wid * 64 + lane;
        PG8_LAS f32x2* P = (PG8_LAS f32x2*)xl; PG8_LAS f32x2* S = (PG8_LAS f32x2*)(xl + 8192);
        const int row0 = u.pm * BM + wr * 64 + fr, col0 = u.pn * BM + wc * 32 + 8 * fq;
#pragma unroll
        for (int ai = 0; ai < 2; ++ai)
#pragma unroll
            for (int m = 0; m < 4; ++m) {
                const size_t off = (size_t)(row0 + ai * HALF + m * 16) * DM + col0; float s = 0.f, ss = 0.f;
#pragma unroll
                for (int bj = 0; bj < 2; ++bj) {
                    f32x4 r0, r1;
                    if (xp) { r0 = *(const f32x4*)(xp + off + bj * HALF); r1 = *(const f32x4*)(xp + off + bj * HALF + 4); }
                    else { const u32x4 w = *(const u32x4*)(XBres + off + bj * HALF);
                        r0 = (f32x4){__uint_as_float(w.x << 16), __uint_as_float(w.x & 0xffff0000u), __uint_as_float(w.y << 16), __uint_as_float(w.y & 0xffff0000u)};
                        r1 = (f32x4){__uint_as_float(w.z << 16), __uint_as_float(w.z & 0xffff0000u), __uint_as_float(w.w << 16), __uint_as_float(w.w & 0xffff0000u)}; }
                    const f32x4 v0 = r0 * ALPHA + acc[ai][bj][m][0], v1 = r1 * ALPHA + acc[ai][bj][m][1];
                    acc[ai][bj][m][0] = v0; acc[ai][bj][m][1] = v1;
                    s += ((v0[0] + v0[1]) + (v0[2] + v0[3])) + ((v1[0] + v1[1]) + (v1[2] + v1[3]));
                    ss += ((v0[0] * v0[0] + v0[1] * v0[1]) + (v0[2] * v0[2] + v0[3] * v0[3])) + ((v1[0] * v1[0] + v1[1] * v1[1]) + (v1[2] * v1[2] + v1[3] * v1[3]));
                }
                s += __shfl_xor(s, 16); s += __shfl_xor(s, 32); ss += __shfl_xor(ss, 16); ss += __shfl_xor(ss, 32);
                if (fq == 0) P[(ai * HALF + wr * 64 + m * 16 + fr) * 4 + wc] = (f32x2){s, ss};
            }
        asm volatile("s_waitcnt lgkmcnt(0)" ::: "memory"); __builtin_amdgcn_s_barrier(); asm volatile("" ::: "memory");
        if (tid < 256) {
            const f32x2 a = P[tid * 4 + 0], bb = P[tid * 4 + 1], c = P[tid * 4 + 2], d = P[tid * 4 + 3];
            const float ts0 = (a.x + bb.x) + (c.x + d.x), tss0 = (a.y + bb.y) + (c.y + d.y);
            unsigned long long* slot = xbuf + (size_t)(u.pm * BM + tid) * 4;
            __hip_atomic_store(slot + u.pn, ((unsigned long long)__float_as_uint(tss0) << 32) | __float_as_uint(ts0), __ATOMIC_RELAXED, __HIP_MEMORY_SCOPE_AGENT);
            unsigned long long w[4]; bool ok = false;
            for (unsigned sp = 0; sp < (1u << 18); ++sp) {
#pragma unroll
                for (int t = 0; t < 4; ++t) w[t] = __hip_atomic_load(slot + t, __ATOMIC_RELAXED, __HIP_MEMORY_SCOPE_AGENT);
                ok = (w[0] != ~0ull) && (w[1] != ~0ull) && (w[2] != ~0ull) && (w[3] != ~0ull);
                if (!__any(!ok)) break;
                __builtin_amdgcn_s_sleep(1);
            }
            float ts = 0.f, tss = 0.f;
#pragma unroll
            for (int t = 0; t < 4; ++t) { ts += __uint_as_float((unsigned)w[t]); tss += __uint_as_float((unsigned)(w[t] >> 32)); }
            const float mean = ts * (1.0f / DM), var = fmaxf(tss * (1.0f / DM) - mean * mean, 0.f);
            S[tid] = (f32x2){mean, 1.0f / sqrtf(var + LN_EPS)};
        }
        asm volatile("s_waitcnt vmcnt(0) lgkmcnt(0)" ::: "memory"); __builtin_amdgcn_s_barrier(); asm volatile("" ::: "memory");
        f32x4 gv[2][2], bv[2][2];
#pragma unroll
        for (int bj = 0; bj < 2; ++bj)
#pragma unroll
            for (int n = 0; n < 2; ++n) { gv[bj][n] = *(const f32x4*)(g + col0 + bj * HALF + 4 * n); bv[bj][n] = *(const f32x4*)(b + col0 + bj * HALF + 4 * n); }
#pragma unroll
        for (int ai = 0; ai < 2; ++ai)
#pragma unroll
            for (int m = 0; m < 4; ++m) {
                const int r = ai * HALF + wr * 64 + m * 16 + fr; const f32x2 sr = S[r];
                const size_t off = (size_t)(u.pm * BM + r) * DM + col0;
#pragma unroll
                for (int bj = 0; bj < 2; ++bj) {
                    const f32x4 y0 = (acc[ai][bj][m][0] - sr.x) * sr.y * gv[bj][0] + bv[bj][0], y1 = (acc[ai][bj][m][1] - sr.x) * sr.y * gv[bj][1] + bv[bj][1];
                    if (yout) { *(f32x4*)(yout + off + bj * HALF) = y0; *(f32x4*)(yout + off + bj * HALF + 4) = y1; }
                    else { u32x4 o; o.x = cvt_pk_bf16(y0[0], y0[1]); o.y = cvt_pk_bf16(y0[2], y0[3]); o.z = cvt_pk_bf16(y1[0], y1[1]); o.w = cvt_pk_bf16(y1[2], y1[3]);
                        *(u32x4*)(XBout + off + bj * HALF) = o; }
                }
            }
        asm volatile("s_waitcnt lgkmcnt(0)" ::: "memory"); __builtin_amdgcn_s_barrier(); asm volatile("" ::: "memory");
    }
};
struct EpiSoftmax {
    static constexpr bool PERM = true, AFTER_DRAIN = false;
    bf16_t* Pout; PG8_LAS unsigned char* xl;
    __device__ __forceinline__ void operator()(f32x4 (&acc)[2][2][4][2], const Unit& u, int wr, int wc, int fr, int fq) const {
        PG8_LAS float* Pm = (PG8_LAS float*)xl; PG8_LAS float* Ps = (PG8_LAS float*)(xl + 4096);
        const int row0 = u.pm * BM + wr * 64 + fr, col0 = u.pn * BM + wc * 32 + 8 * fq;
#pragma unroll
        for (int ai = 0; ai < 2; ++ai)
#pragma unroll
            for (int m = 0; m < 4; ++m) { float mx = -1e30f;
#pragma unroll
                for (int bj = 0; bj < 2; ++bj)
#pragma unroll
                    for (int n = 0; n < 2; ++n) { const f32x4 v = acc[ai][bj][m][n]; mx = fmaxf(mx, fmaxf(fmaxf(v[0], v[1]), fmaxf(v[2], v[3]))); }
                mx = fmaxf(mx, __shfl_xor(mx, 16)); mx = fmaxf(mx, __shfl_xor(mx, 32));
                if (fq == 0) Pm[(ai * HALF + wr * 64 + m * 16 + fr) * 4 + wc] = mx; }
        asm volatile("s_waitcnt lgkmcnt(0)" ::: "memory"); __builtin_amdgcn_s_barrier(); asm volatile("" ::: "memory");
#pragma unroll
        for (int ai = 0; ai < 2; ++ai)
#pragma unroll
            for (int m = 0; m < 4; ++m) { const int r = ai * HALF + wr * 64 + m * 16 + fr; const f32x4 q = *(const PG8_LAS f32x4*)(Pm + r * 4);
                const float mx = fmaxf(fmaxf(q[0], q[1]), fmaxf(q[2], q[3])); float sm = 0.f;
#pragma unroll
                for (int bj = 0; bj < 2; ++bj)
#pragma unroll
                    for (int n = 0; n < 2; ++n) { f32x4 v = acc[ai][bj][m][n];
#pragma unroll
                        for (int e = 0; e < 4; ++e) { v[e] = __expf(v[e] - mx); sm += v[e]; }
                        acc[ai][bj][m][n] = v; }
                sm += __shfl_xor(sm, 16); sm += __shfl_xor(sm, 32);
                if (fq == 0) Ps[r * 4 + wc] = sm; }
        asm volatile("s_waitcnt lgkmcnt(0)" ::: "memory"); __builtin_amdgcn_s_barrier(); asm volatile("" ::: "memory");
#pragma unroll
        for (int ai = 0; ai < 2; ++ai)
#pragma unroll
            for (int m = 0; m < 4; ++m) { const int r = ai * HALF + wr * 64 + m * 16 + fr; const f32x4 q = *(const PG8_LAS f32x4*)(Ps + r * 4);
                const float inv = 1.0f / ((q[0] + q[1]) + (q[2] + q[3]));
                bf16_t* rowp = Pout + (size_t)(u.pm * BM + r) * DM + col0;
#pragma unroll
                for (int bj = 0; bj < 2; ++bj) { const f32x4 v0 = acc[ai][bj][m][0] * inv, v1 = acc[ai][bj][m][1] * inv;
                    u32x4 w; w.x = cvt_pk_bf16(v0[0], v0[1]); w.y = cvt_pk_bf16(v0[2], v0[3]); w.z = cvt_pk_bf16(v1[0], v1[1]); w.w = cvt_pk_bf16(v1[2], v1[3]);
                    *(u32x4*)(rowp + bj * HALF) = w; } }
        asm volatile("s_waitcnt lgkmcnt(0)" ::: "memory"); __builtin_amdgcn_s_barrier(); asm volatile("" ::: "memory");
    }
};
template <class Epi, class Sched, bool ALIGN_EPI = false, bool SP2 = false>
__device__ __forceinline__ void gemm_phase(PG8_LAS unsigned char* lds, const Gemm g, const Sched& S, const Epi& E) {
    int tid_ = threadIdx.x; asm volatile("" : "+v"(tid_)); const int tid = tid_, wid = __builtin_amdgcn_readfirstlane(tid >> 6), lane = tid & 63, wr = wid >> 2, wc = wid & 3, fr = lane & 15, fq = lane >> 4;
    const int K = g.K, nt = K / BK;
    unsigned voffA[2], voffB[2];
#pragma unroll
    for (int i = 0; i < 2; ++i) { int R, C; stage_rc(tid * 16 + i * 8192, R, C); const int Rb = Epi::PERM ? ((R & ~31) + perm32(R & 31)) : R;
        voffA[i] = (unsigned)(R * g.lda + C) * 2u; voffB[i] = (unsigned)(Rb * g.ldb + C) * 2u; }
    const size_t kstep = (size_t)(BK * 2);
    const size_t hstepA = (size_t)HALF * g.lda * 2, hstepB = (size_t)HALF * g.ldb * 2;
    const unsigned ldsw = (unsigned)wid * 1024u;
    const int aoff = lds_byte(wr * 64 + fr, fq * 8), boff = lds_byte(wc * 32 + fr, fq * 8);
#define PG8_SA(b, h) (((b) * 2 + (h)) * HTB)
#define PG8_SB(b, h) ((4 + (b) * 2 + (h)) * HTB)
#define PG8_STAGE(bufoff, gbase, voff) do { _Pragma("unroll") for (int _i = 0; _i < 2; ++_i) \
        __builtin_amdgcn_global_load_lds((const unsigned*)((const char*)(gbase) + (voff)[_i]), (PG8_LAS unsigned*)(lds + (bufoff) + ldsw + _i * 8192), 16, 0, 0); } while (0)
#define PG8_LDA(dst, b, h) do { _Pragma("unroll") for (int m = 0; m < 4; ++m) _Pragma("unroll") for (int k = 0; k < 2; ++k) dst[m][k] = *(const PG8_LAS bf16x8*)(lds + PG8_SA(b, h) + aoff + m * 2048 + k * 1024); } while (0)
#define PG8_LDB(dst, b, h) do { _Pragma("unroll") for (int n = 0; n < 2; ++n) _Pragma("unroll") for (int k = 0; k < 2; ++k) dst[n][k] = *(const PG8_LAS bf16x8*)(lds + PG8_SB(b, h) + boff + n * 2048 + k * 1024); } while (0)
#define PG8_MMA(ai, bj, At, Bt) do { __builtin_amdgcn_s_setprio(1); _Pragma("unroll") for (int m = 0; m < 4; ++m) _Pragma("unroll") for (int n = 0; n < 2; ++n) _Pragma("unroll") for (int k = 0; k < 2; ++k) \
        acc[ai][bj][m][n] = __builtin_amdgcn_mfma_f32_16x16x32_bf16(Bt[n][k], At[m][k], acc[ai][bj][m][n], 0, 0, 0); __builtin_amdgcn_s_setprio(0); } while (0)
#define PG8_WAIT_V(n) asm volatile("s_waitcnt vmcnt(" #n ")" ::: "memory")
#define PG8_WAIT_L(n) asm volatile("s_waitcnt lgkmcnt(" #n ")" ::: "memory")
#define PG8_BAR __builtin_amdgcn_s_barrier()
#define PG8_SCHED __builtin_amdgcn_sched_barrier(0)
    Unit cur, nxt; int ui = 0;
    if (!S.next(0, cur)) return;
    f32x4 acc[2][2][4][2];
#pragma unroll
    for (int a = 0; a < 2; ++a)
#pragma unroll
        for (int b = 0; b < 2; ++b)
#pragma unroll
            for (int m = 0; m < 4; ++m)
#pragma unroll
                for (int n = 0; n < 2; ++n) acc[a][b][m][n] = (f32x4){0.f, 0.f, 0.f, 0.f};
    bf16x8 At[4][2], B0[2][2], B1[2][2];
    const char* cA = (const char*)g.A + g.aoff(cur); const char* cB = (const char*)g.Bt + g.boff(cur);
    S.a_ready(cur);
    if constexpr (SP2) {
        PG8_STAGE(PG8_SB(0, 0), cB, voffB); PG8_STAGE(PG8_SB(0, 1), cB + hstepB, voffB); PG8_STAGE(PG8_SA(0, 0), cA, voffA); PG8_STAGE(PG8_SA(0, 1), cA + hstepA, voffA);
        if (wr == 1) PG8_BAR;
        PG8_WAIT_V(2); PG8_BAR;
        PG8_STAGE(PG8_SB(1, 0), cB + kstep, voffB); PG8_STAGE(PG8_SA(1, 0), cA + kstep, voffA); PG8_STAGE(PG8_SB(1, 1), cB + hstepB + kstep, voffB);
        PG8_WAIT_V(6); PG8_BAR;
    } else {
        PG8_STAGE(PG8_SB(0, 0), cB, voffB); PG8_STAGE(PG8_SA(0, 0), cA, voffA); PG8_STAGE(PG8_SB(0, 1), cB + hstepB, voffB); PG8_STAGE(PG8_SA(0, 1), cA + hstepA, voffA);
        if (wr == 1) PG8_BAR;
        PG8_WAIT_V(4); PG8_BAR;
        PG8_STAGE(PG8_SB(1, 0), cB + kstep, voffB); PG8_STAGE(PG8_SA(1, 0), cA + kstep, voffA); PG8_STAGE(PG8_SB(1, 1), cB + hstepB + kstep, voffB);
        PG8_WAIT_V(6); PG8_BAR;
    }
    for (;;) {
        const bool has_next = S.next(ui + 1, nxt);
        const char* nA = has_next ? (const char*)g.A + g.aoff(nxt) : cA; const char* nB = has_next ? (const char*)g.Bt + g.boff(nxt) : cB;
        for (int t = 0; t < nt; t += 2) {
            const bool last = (t == nt - 2);
            const char* a1 = cA + (size_t)(t + 1) * kstep;
            const char* a2 = last ? nA : cA + (size_t)(t + 2) * kstep; const char* b2 = last ? nB : cB + (size_t)(t + 2) * kstep;
            const char* a3 = a2 + kstep; const char* b3 = b2 + kstep;
            if (last && has_next) S.a_ready(nxt);
            if constexpr (SP2) {
            PG8_LDB(B0, 0, 0); PG8_LDB(B1, 0, 1); PG8_SCHED; PG8_LDA(At, 0, 0); PG8_STAGE(PG8_SA(1, 1), a1 + hstepA, voffA);
            PG8_WAIT_V(8); PG8_WAIT_L(0); PG8_BAR; PG8_MMA(0, 0, At, B0); PG8_MMA(0, 1, At, B1); PG8_BAR; PG8_SCHED;
            PG8_LDA(At, 0, 1); PG8_STAGE(PG8_SB(0, 0), b2, voffB); PG8_STAGE(PG8_SB(0, 1), b2 + hstepB, voffB); PG8_STAGE(PG8_SA(0, 0), a2, voffA);
            PG8_WAIT_V(8); PG8_WAIT_L(0); PG8_BAR; PG8_MMA(1, 0, At, B0); PG8_MMA(1, 1, At, B1); PG8_BAR; PG8_SCHED;
            PG8_LDB(B0, 1, 0); PG8_LDB(B1, 1, 1); PG8_SCHED; PG8_LDA(At, 1, 0); PG8_STAGE(PG8_SA(0, 1), a2 + hstepA, voffA);
            PG8_WAIT_V(8); PG8_WAIT_L(0); PG8_BAR; PG8_MMA(0, 0, At, B0); PG8_MMA(0, 1, At, B1); PG8_BAR; PG8_SCHED;
            PG8_LDA(At, 1, 1); PG8_STAGE(PG8_SB(1, 0), b3, voffB); PG8_STAGE(PG8_SB(1, 1), b3 + hstepB, voffB); PG8_STAGE(PG8_SA(1, 0), a3, voffA);
            PG8_WAIT_V(8); PG8_WAIT_L(0); PG8_BAR; PG8_MMA(1, 0, At, B0); PG8_MMA(1, 1, At, B1); PG8_BAR; PG8_SCHED;
            } else {
            PG8_LDB(B0, 0, 0); PG8_SCHED; PG8_LDA(At, 0, 0); PG8_STAGE(PG8_SA(1, 1), a1 + hstepA, voffA);
            PG8_WAIT_L(8); PG8_BAR; PG8_WAIT_L(0); PG8_MMA(0, 0, At, B0); PG8_BAR; PG8_SCHED;
            PG8_LDB(B1, 0, 1); PG8_STAGE(PG8_SB(0, 0), b2, voffB);
            PG8_BAR; PG8_WAIT_L(0); PG8_MMA(0, 1, At, B1); PG8_BAR;
            PG8_LDA(At, 0, 1); PG8_STAGE(PG8_SA(0, 0), a2, voffA);
            PG8_BAR; PG8_WAIT_L(0); PG8_MMA(1, 0, At, B0); PG8_BAR; PG8_SCHED;
            PG8_STAGE(PG8_SB(0, 1), b2 + hstepB, voffB);
            PG8_WAIT_V(6); PG8_BAR; PG8_MMA(1, 1, At, B1); PG8_BAR;
            PG8_LDB(B0, 1, 0); PG8_SCHED; PG8_LDA(At, 1, 0); PG8_STAGE(PG8_SA(0, 1), a2 + hstepA, voffA);
            PG8_WAIT_L(8); PG8_BAR; PG8_WAIT_L(0); PG8_MMA(0, 0, At, B0); PG8_BAR; PG8_SCHED;
            PG8_LDB(B1, 1, 1); PG8_STAGE(PG8_SB(1, 0), b3, voffB);
            PG8_BAR; PG8_WAIT_L(0); PG8_MMA(0, 1, At, B1); PG8_BAR;
            PG8_LDA(At, 1, 1); PG8_STAGE(PG8_SA(1, 0), a3, voffA);
            PG8_BAR; PG8_WAIT_L(0); PG8_MMA(1, 0, At, B0); PG8_BAR; PG8_SCHED;
            PG8_STAGE(PG8_SB(1, 1), b3 + hstepB, voffB);
            PG8_WAIT_V(6); PG8_BAR; PG8_MMA(1, 1, At, B1); PG8_BAR;
            }
        }
        if constexpr (ALIGN_EPI) { if (wr == 0) PG8_BAR; }
        if constexpr (!Epi::AFTER_DRAIN) { E(acc, cur, wr, wc, fr, fq); S.done(cur); }
        if (!has_next) break;
#pragma unroll
        for (int a = 0; a < 2; ++a)
#pragma unroll
            for (int b = 0; b < 2; ++b)
#pragma unroll
                for (int m = 0; m < 4; ++m)
#pragma unroll
                    for (int n = 0; n < 2; ++n) acc[a][b][m][n] = (f32x4){0.f, 0.f, 0.f, 0.f};
        cur = nxt; cA = nA; cB = nB; ++ui;
        if constexpr (ALIGN_EPI) { if (wr == 1) PG8_BAR; }
    }
    PG8_WAIT_V(0);
    if constexpr (!ALIGN_EPI) { if (wr == 0) PG8_BAR; }
    PG8_BAR;
    if constexpr (Epi::AFTER_DRAIN) { E.fused(acc, cur, wr, wc, fr, fq, lds, wid, lane); S.done(cur); }
#undef PG8_SA
#undef PG8_SB
#undef PG8_STAGE
#undef PG8_LDA
#undef PG8_LDB
#undef PG8_MMA
#undef PG8_WAIT_V
#undef PG8_WAIT_L
#undef PG8_BAR
#undef PG8_SCHED
}
}

#define LAS __attribute__((address_space(3)))
typedef unsigned short bf16_t;
using pg8::bf16x8; using pg8::f32x4; using pg8::u32x4; using pg8::u32x2;
typedef float f32x2 __attribute__((ext_vector_type(2)));

struct Params { const float* in[20]; float* out; unsigned char* ws; };

__device__ __forceinline__ int fresh_tid() { int t = threadIdx.x; asm volatile("" : "+v"(t)); return t; }
__device__ __forceinline__ unsigned pkbf(float lo, float hi) { return pg8::cvt_pk_bf16(lo, hi); }
__device__ __forceinline__ float bflo(unsigned u) { return __uint_as_float(u << 16); }
__device__ __forceinline__ float bfhi(unsigned u) { return __uint_as_float(u & 0xffff0000u); }
__device__ __forceinline__ float sigm(float x) { return __builtin_amdgcn_rcpf(1.0f + __expf(-x)); }
__device__ __forceinline__ f32x4 mfma16(bf16x8 x, bf16x8 y, f32x4 c) { return __builtin_amdgcn_mfma_f32_16x16x32_bf16(x, y, c, 0, 0, 0); }
__device__ __forceinline__ bf16x8 ldsfrag(const LAS unsigned char* p) { return *(const LAS bf16x8*)p; }
__device__ __forceinline__ bf16x8 mk8(unsigned a, unsigned b, unsigned c, unsigned d) { u32x4 v = (u32x4){a, b, c, d}; return __builtin_bit_cast(bf16x8, v); }

__device__ __forceinline__ void st8_wt(void* p, u32x2 v) { __hip_atomic_store((unsigned long long*)p, (unsigned long long)v.x | ((unsigned long long)v.y << 32), __ATOMIC_RELAXED, __HIP_MEMORY_SCOPE_AGENT); }
__device__ __forceinline__ void lds_barrier() { asm volatile("s_waitcnt lgkmcnt(0)" ::: "memory"); __builtin_amdgcn_s_barrier(); asm volatile("" ::: "memory"); }
#define SB() __builtin_amdgcn_sched_barrier(0)
__device__ __forceinline__ void transpose_item(const float* W, int K, int N, bf16_t* WT, LAS float* scr, int item, int lane, int mode) {
    const int nblk = N / 32, kb = item / nblk, nb = item % nblk, k0 = 64 * kb, n0 = 32 * nb;
    int d0 = n0;
    if (mode == 1) { const int j = (n0 < DFF) ? n0 : n0 - DFF; d0 = 256 * (j / 128) + (j % 128) + ((n0 < DFF) ? 0 : 128); }
#pragma unroll 8
    for (int i = 0; i < 32; ++i) { const int kk = 2 * i + (lane >> 5); scr[kk * 33 + (lane & 31)] = W[(size_t)(k0 + kk) * N + n0 + (lane & 31)]; }
    asm volatile("s_waitcnt lgkmcnt(0)" ::: "memory");
    const int c = lane & 7;
#pragma unroll
    for (int j = 0; j < 4; ++j) { const int n = (lane >> 3) + 8 * j; const LAS float* s = scr + (8 * c) * 33 + n;
        u32x4 o; o.x = pkbf(s[0 * 33], s[1 * 33]); o.y = pkbf(s[2 * 33], s[3 * 33]); o.z = pkbf(s[4 * 33], s[5 * 33]); o.w = pkbf(s[6 * 33], s[7 * 33]);
        *(u32x4*)(WT + (size_t)(d0 + n) * K + k0 + 8 * c) = o; }
    asm volatile("s_waitcnt lgkmcnt(0)" ::: "memory");
}
__device__ __forceinline__ void cvt_copy(const float* src, bf16_t* dst, size_t n8, size_t gt, size_t nt) {
    size_t i = gt;
    for (; i + nt < n8; i += 2 * nt) {
        const f32x4 a0 = __builtin_nontemporal_load((const f32x4*)(src + i * 8)), b0 = __builtin_nontemporal_load((const f32x4*)(src + i * 8 + 4));
        const f32x4 a1 = __builtin_nontemporal_load((const f32x4*)(src + (i + nt) * 8)), b1 = __builtin_nontemporal_load((const f32x4*)(src + (i + nt) * 8 + 4));
        u32x4 o0, o1; o0.x = pkbf(a0[0], a0[1]); o0.y = pkbf(a0[2], a0[3]); o0.z = pkbf(b0[0], b0[1]); o0.w = pkbf(b0[2], b0[3]);
        o1.x = pkbf(a1[0], a1[1]); o1.y = pkbf(a1[2], a1[3]); o1.z = pkbf(b1[0], b1[1]); o1.w = pkbf(b1[2], b1[3]);
        *(u32x4*)(dst + i * 8) = o0; *(u32x4*)(dst + (i + nt) * 8) = o1; }
    for (; i < n8; i += nt) { const f32x4 a = __builtin_nontemporal_load((const f32x4*)(src + i * 8)), b = __builtin_nontemporal_load((const f32x4*)(src + i * 8 + 4));
        u32x4 o; o.x = pkbf(a[0], a[1]); o.y = pkbf(a[2], a[3]); o.z = pkbf(b[0], b[1]); o.w = pkbf(b[2], b[3]); *(u32x4*)(dst + i * 8) = o; }
}
__device__ __forceinline__ void zero16(void* dst, size_t n16, size_t gt, size_t nt) { for (size_t i = gt; i < n16; i += nt) ((u32x4*)dst)[i] = (u32x4){0u, 0u, 0u, 0u}; }

constexpr int HG_QG = 0, HG_KG = 17408, HG_KDT = 34816, HG_VT = 53248, HG_ST = 71680, HG_AL = 106496, HG_PART = 115712, HG_EGL = 119808, HG_SSQ = 120320;
template <int L, int NCHUNK, bool HAS_S0>
__device__ __forceinline__ void hgrn_item(const bf16_t* __restrict__ Z, bf16_t* __restrict__ MIX, const float* __restrict__ lbl, const float* __restrict__ gnorm,
                                          const float* __restrict__ S0, float* __restrict__ Sout, LAS unsigned char* lds, int rowbase, int h) {
    constexpr int nchunk = NCHUNK;
    const int tid = fresh_tid(), lane = tid & 63, w = __builtin_amdgcn_readfirstlane(tid >> 6), fr = lane & 15, fq = lane >> 4;
    LAS unsigned char* QG = lds + HG_QG; LAS unsigned char* KG = lds + HG_KG; LAS unsigned char* KDT = lds + HG_KDT; LAS unsigned char* VT = lds + HG_VT;
    LAS unsigned char* STL = lds + HG_ST; LAS unsigned char* AL = lds + HG_AL;
    LAS float* PART = (LAS float*)(lds + HG_PART); LAS float* EGL = (LAS float*)(lds + HG_EGL); LAS float* SSQ = (LAS float*)(lds + HG_SSQ);
    const int ch = 2 * lane;
    float lb0, lb1;
    { const float a0 = lbl[h * 128 + ch], a1 = lbl[512 + h * 128 + ch], b0 = lbl[h * 128 + ch + 1], b1 = lbl[512 + h * 128 + ch + 1];
      lb0 = 1.0f / (1.0f + __expf(a1 - a0)); lb1 = 1.0f / (1.0f + __expf(b1 - b0)); }
    f32x4 S[8];
#pragma unroll
    for (int dt = 0; dt < 8; ++dt)
#pragma unroll
        for (int i = 0; i < 4; ++i) S[dt][i] = HAS_S0 ? S0[(16 * w + 4 * fq + i) * 128 + 16 * dt + fr] : 0.f;
    unsigned rq[8], rf[8], ri[8]; u32x2 hgn[4];
    const int tt = w >> 1, dh = w & 1, tok = 16 * tt + fr; const bool tvalid = tok < L;
#define HG_LOAD(c_) do { _Pragma("unroll") for (int i = 0; i < 8; ++i) { const bf16_t* zp = Z + (size_t)(rowbase + (c_) * 64 + 8 * w + i) * INC + h * 128 + ch; \
        if (8 * w + i < L) { rq[i] = *(const unsigned*)(zp + ZC_HQ); rf[i] = *(const unsigned*)(zp + ZC_HF); ri[i] = *(const unsigned*)(zp + ZC_HI); } else { rq[i] = 0u; rf[i] = 0u; ri[i] = 0u; } } \
        _Pragma("unroll") for (int j = 0; j < 4; ++j) hgn[j] = tvalid ? *(const u32x2*)(Z + (size_t)(rowbase + (c_) * 64 + tok) * INC + ZC_HG + h * 128 + 16 * (4 * dh + j) + 4 * fq) : (u32x2){0u, 0u}; } while (0)
    HG_LOAD(0);
    f32x4 oP[4]; u32x2 hgP[4]; size_t rowP = 0;
#define HG_EPILOGUE() do { const f32x2 sq_ = *(const LAS f32x2*)(SSQ + tok * 2); const float rstd_ = rsqrtf((sq_.x + sq_.y) * (1.0f / 128.0f) + 1e-6f); \
        if (tvalid) { _Pragma("unroll") for (int j = 0; j < 4; ++j) { const int dv_ = 16 * (4 * dh + j) + 4 * fq; const f32x4 gn_ = *(const f32x4*)(gnorm + dv_); \
            const float g0_ = bflo(hgP[j].x), g1_ = bfhi(hgP[j].x), g2_ = bflo(hgP[j].y), g3_ = bfhi(hgP[j].y);     \
            *(u32x2*)(MIX + rowP * DM + h * 128 + dv_) = (u32x2){pkbf(oP[j][0] * rstd_ * gn_[0] * g0_, oP[j][1] * rstd_ * gn_[1] * g1_), pkbf(oP[j][2] * rstd_ * gn_[2] * g2_, oP[j][3] * rstd_ * gn_[3] * g3_)}; } } } while (0)
    for (int c = 0; c < nchunk; ++c) {
        float P0[8], P1[8], k0[8], k1[8];
        { float c0 = 1.f, c1 = 1.f;
#pragma unroll
          for (int i = 0; i < 8; ++i) { const bool valid = (8 * w + i < L);
              const float f0 = lb0 + (1.0f - lb0) * sigm(bflo(rf[i])), f1 = lb1 + (1.0f - lb1) * sigm(bfhi(rf[i]));
              c0 *= valid ? f0 : 1.f; c1 *= valid ? f1 : 1.f; P0[i] = c0; P1[i] = c1; k0[i] = valid ? 1.0f - f0 : 0.f; k1[i] = valid ? 1.0f - f1 : 0.f; }
          *(LAS f32x2*)(PART + w * 128 + ch) = (f32x2){c0, c1}; }
        lds_barrier();
        if (c > 0) HG_EPILOGUE();
        float pre0 = 1.f, pre1 = 1.f, GL0 = 1.f, GL1 = 1.f;
#pragma unroll
        for (int ww = 0; ww < 8; ++ww) { const f32x2 p = *(const LAS f32x2*)(PART + ww * 128 + ch); GL0 *= p.x; GL1 *= p.y; if (ww < w) { pre0 *= p.x; pre1 *= p.y; } }
        { unsigned kd0[4], kd1[4];
#pragma unroll
          for (int i = 0; i < 8; ++i) { const float e0 = pre0 * P0[i], e1 = pre1 * P1[i], r0 = __builtin_amdgcn_rcpf(e0), r1 = __builtin_amdgcn_rcpf(e1);
              const float q0 = bflo(rq[i]), q1 = bfhi(rq[i]);
              *(LAS unsigned*)(QG + (8 * w + i) * 272 + ch * 2) = pkbf(q0 * e0, q1 * e1);
              const float kg0 = k0[i] * r0, kg1 = k1[i] * r1;
              *(LAS unsigned*)(KG + (8 * w + i) * 272 + ch * 2) = pkbf(kg0, kg1);
              k0[i] = kg0 * GL0; k1[i] = kg1 * GL1; }
#pragma unroll
          for (int i = 0; i < 4; ++i) { kd0[i] = pkbf(k0[2 * i], k0[2 * i + 1]); kd1[i] = pkbf(k1[2 * i], k1[2 * i + 1]); }
          *(LAS u32x4*)(KDT + ch * 144 + 16 * w) = (u32x4){kd0[0], kd0[1], kd0[2], kd0[3]};
          *(LAS u32x4*)(KDT + (ch + 1) * 144 + 16 * w) = (u32x4){kd1[0], kd1[1], kd1[2], kd1[3]};
          u32x4 va, vb;
          va.x = (ri[0] & 0xffffu) | (ri[1] << 16); va.y = (ri[2] & 0xffffu) | (ri[3] << 16); va.z = (ri[4] & 0xffffu) | (ri[5] << 16); va.w = (ri[6] & 0xffffu) | (ri[7] << 16);
          vb.x = (ri[0] >> 16) | (ri[1] & 0xffff0000u); vb.y = (ri[2] >> 16) | (ri[3] & 0xffff0000u); vb.z = (ri[4] >> 16) | (ri[5] & 0xffff0000u); vb.w = (ri[6] >> 16) | (ri[7] & 0xffff0000u);
          *(LAS u32x4*)(VT + ch * 144 + 16 * w) = va; *(LAS u32x4*)(VT + (ch + 1) * 144 + 16 * w) = vb; }
        if (w == 0) *(LAS f32x2*)(EGL + ch) = (f32x2){GL0, GL1};
#pragma unroll
        for (int dt = 0; dt < 8; ++dt) *(LAS u32x2*)(STL + (16 * dt + fr) * 272 + (16 * w + 4 * fq) * 2) = (u32x2){pkbf(S[dt][0], S[dt][1]), pkbf(S[dt][2], S[dt][3])};
        u32x2 hg[4];
#pragma unroll
        for (int j = 0; j < 4; ++j) hg[j] = hgn[j];
        if (c + 1 < nchunk) HG_LOAD(c + 1);
        lds_barrier();
        { const f32x4 eg = *(const LAS f32x4*)(EGL + 16 * w + 4 * fq);
          const bf16x8 xk0 = ldsfrag(KDT + (16 * w + fr) * 144 + (8 * fq) * 2), xk1 = ldsfrag(KDT + (16 * w + fr) * 144 + (32 + 8 * fq) * 2);
#pragma unroll
          for (int b4 = 0; b4 < 2; ++b4) { bf16x8 v0[4], v1[4];
#pragma unroll
              for (int d = 0; d < 4; ++d) { v0[d] = ldsfrag(VT + (16 * (4 * b4 + d) + fr) * 144 + (8 * fq) * 2); v1[d] = ldsfrag(VT + (16 * (4 * b4 + d) + fr) * 144 + (32 + 8 * fq) * 2); }
#pragma unroll
              for (int d = 0; d < 4; ++d) S[4 * b4 + d] = S[4 * b4 + d] * eg;
              SB();
#pragma unroll
              for (int d = 0; d < 4; ++d) S[4 * b4 + d] = mfma16(xk0, v0[d], S[4 * b4 + d]);
#pragma unroll
              for (int d = 0; d < 4; ++d) S[4 * b4 + d] = mfma16(xk1, v1[d], S[4 * b4 + d]);
              SB(); } }
        { const int st0 = 2 * (w & 1); f32x4 a[2]; a[0] = (f32x4){0.f, 0.f, 0.f, 0.f}; a[1] = a[0];
          if (st0 <= tt) { bf16x8 qf[4], kf[2][4];
#pragma unroll
              for (int kb = 0; kb < 4; ++kb) { qf[kb] = ldsfrag(QG + (16 * tt + fr) * 272 + (32 * kb + 8 * fq) * 2);
                  kf[0][kb] = ldsfrag(KG + (16 * st0 + fr) * 272 + (32 * kb + 8 * fq) * 2); kf[1][kb] = ldsfrag(KG + (16 * (st0 + 1) + fr) * 272 + (32 * kb + 8 * fq) * 2); }
              SB();
#pragma unroll
              for (int kb = 0; kb < 4; ++kb) { a[0] = mfma16(kf[0][kb], qf[kb], a[0]); a[1] = mfma16(kf[1][kb], qf[kb], a[1]); }
              SB(); }
#pragma unroll
          for (int j = 0; j < 2; ++j) { const int st = st0 + j;
              if (st > tt) a[j] = (f32x4){0.f, 0.f, 0.f, 0.f};
              if (st == tt) {
#pragma unroll
                  for (int i = 0; i < 4; ++i) if (4 * fq + i > fr) a[j][i] = 0.f; }
              *(LAS u32x2*)(AL + (16 * tt + fr) * 144 + (16 * st + 4 * fq) * 2) = (u32x2){pkbf(a[j][0], a[j][1]), pkbf(a[j][2], a[j][3])}; } }
        lds_barrier();
        { const size_t row = (size_t)(rowbase + c * 64 + tok);
          bf16x8 ya[2], yq[4];
#pragma unroll
          for (int kb = 0; kb < 2; ++kb) ya[kb] = ldsfrag(AL + (16 * tt + fr) * 144 + (32 * kb + 8 * fq) * 2);
#pragma unroll
          for (int kb = 0; kb < 4; ++kb) yq[kb] = ldsfrag(QG + (16 * tt + fr) * 272 + (32 * kb + 8 * fq) * 2);
          f32x4 o[4]; float ss = 0.f;
#pragma unroll
          for (int jp = 0; jp < 2; ++jp) { bf16x8 vf[2][2], sf[2][4];
#pragma unroll
              for (int t = 0; t < 2; ++t) { const int dt = 4 * dh + 2 * jp + t;
#pragma unroll
                  for (int kb = 0; kb < 2; ++kb) vf[t][kb] = ldsfrag(VT + (16 * dt + fr) * 144 + (32 * kb + 8 * fq) * 2);
#pragma unroll
                  for (int kb = 0; kb < 4; ++kb) sf[t][kb] = ldsfrag(STL + (16 * dt + fr) * 272 + (32 * kb + 8 * fq) * 2); }
              SB();
              o[2 * jp] = (f32x4){0.f, 0.f, 0.f, 0.f}; o[2 * jp + 1] = (f32x4){0.f, 0.f, 0.f, 0.f};
#pragma unroll
              for (int kb = 0; kb < 2; ++kb) { o[2 * jp] = mfma16(vf[0][kb], ya[kb], o[2 * jp]); o[2 * jp + 1] = mfma16(vf[1][kb], ya[kb], o[2 * jp + 1]); }
#pragma unroll
              for (int kb = 0; kb < 4; ++kb) { o[2 * jp] = mfma16(sf[0][kb], yq[kb], o[2 * jp]); o[2 * jp + 1] = mfma16(sf[1][kb], yq[kb], o[2 * jp + 1]); }
              SB(); }
#pragma unroll
          for (int j = 0; j < 4; ++j) ss += (o[j][0] * o[j][0] + o[j][1] * o[j][1]) + (o[j][2] * o[j][2] + o[j][3] * o[j][3]);
          ss += __shfl_xor(ss, 16); ss += __shfl_xor(ss, 32);
          if (fq == 0) SSQ[tok * 2 + dh] = ss;
#pragma unroll
          for (int j = 0; j < 4; ++j) { oP[j] = o[j]; hgP[j] = hg[j]; }
          rowP = row; }
    }
    lds_barrier();
    HG_EPILOGUE();
#undef HG_LOAD
#undef HG_EPILOGUE
#pragma unroll
    for (int dt = 0; dt < 8; ++dt)
#pragma unroll
        for (int i = 0; i < 4; ++i) Sout[(16 * w + 4 * fq + i) * 128 + 16 * dt + fr] = S[dt][i];
    __syncthreads();
}

constexpr int SW_K = 0, SW_VT = 27648;
template <int SAMPLE>
__device__ __forceinline__ void swa_item(const bf16_t* __restrict__ Z, bf16_t* __restrict__ MIX, const float* __restrict__ ck, const float* __restrict__ cv, const float* __restrict__ sinks,
                                         LAS unsigned char* lds, int b, int c, int hk) {
    const int tid = fresh_tid(), lane = tid & 63, w = __builtin_amdgcn_readfirstlane(tid >> 6), fr = lane & 15, fq = lane >> 4;
    LAS unsigned char* KL = lds + SW_K; LAS unsigned char* VTL = lds + SW_VT;
    const int krow0 = SAMPLE ? 0 : b * SEQ + (c - 2) * 64;
    u32x4 kv[3]; unsigned vv[2][8];
    const int dp = tid & 31, gk = tid >> 5;
    if (SAMPLE) {
#pragma unroll
        for (int it = 0; it < 2; ++it) { const int idx = tid + 512 * it, j = idx >> 3, c16 = idx & 7;
            const float* sp = ck + ((size_t)(b * 128 + j) * 2 + hk) * 64 + c16 * 8; const f32x4 a = *(const f32x4*)sp, bb = *(const f32x4*)(sp + 4);
            kv[it] = (u32x4){pkbf(a[0], a[1]), pkbf(a[2], a[3]), pkbf(bb[0], bb[1]), pkbf(bb[2], bb[3])}; }
        { const int idx = tid + 1024, j = idx >> 3, c16 = idx & 7; const bool ok = j < 144;
          const u32x4 t = *(const u32x4*)(Z + (size_t)(MP + b * 16 + (ok ? j - 128 : 0)) * INC + ZC_AK + hk * 64 + c16 * 8); kv[2] = ok ? t : (u32x4){0u, 0u, 0u, 0u}; }
#pragma unroll
        for (int i = 0; i < 8; ++i) { const int j = 8 * gk + i; const f32x2 a = *(const f32x2*)(cv + ((size_t)(b * 128 + j) * 2 + hk) * 64 + 2 * dp); vv[0][i] = pkbf(a.x, a.y); }
#pragma unroll
        for (int i = 0; i < 8; ++i) { const int j = 8 * (gk + 16) + i; const bool ok = j < 144;
            const unsigned t = *(const unsigned*)(Z + (size_t)(MP + b * 16 + (ok ? j - 128 : 0)) * INC + ZC_AV + hk * 64 + 2 * dp); vv[1][i] = ok ? t : 0u; }
    } else {
#pragma unroll
        for (int it = 0; it < 3; ++it) { const int idx = tid + 512 * it, j = idx >> 3, c16 = idx & 7; const bool ok = (c - 2 + (j >> 6) >= 0);
            const u32x4 t = *(const u32x4*)(Z + (size_t)(ok ? krow0 + j : b * SEQ) * INC + ZC_AK + hk * 64 + c16 * 8); kv[it] = ok ? t : (u32x4){0u, 0u, 0u, 0u}; }
#pragma unroll
        for (int r = 0; r < 2; ++r)
#pragma unroll
            for (int i = 0; i < 8; ++i) { const int j = (8 * (gk + 16 * r) + i) % 192; const bool ok = (c - 2 + (j >> 6) >= 0);
                const unsigned t = *(const unsigned*)(Z + (size_t)(ok ? krow0 + j : b * SEQ) * INC + ZC_AV + hk * 64 + 2 * dp); vv[r][i] = ok ? t : 0u; }
    }
    const int g = w >> 1, tq0 = 32 * (w & 1), hh = hk * 4 + g;
    bf16x8 yq[2][2]; size_t qrow[2];
#pragma unroll
    for (int qt = 0; qt < 2; ++qt) { const int tok = tq0 + 16 * qt + fr; qrow[qt] = SAMPLE ? (size_t)(MP + b * 16 + (tok & 15)) : (size_t)(b * SEQ + c * 64 + tok);
#pragma unroll
        for (int dk = 0; dk < 2; ++dk) yq[qt][dk] = *(const bf16x8*)(Z + qrow[qt] * INC + ZC_AQ + hk * 256 + g * 64 + 32 * dk + 8 * fq); }
#pragma unroll
    for (int it = 0; it < 3; ++it) { const int idx = tid + 512 * it; *(LAS u32x4*)(KL + (idx >> 3) * 144 + (idx & 7) * 16) = kv[it]; }
#pragma unroll
    for (int r = 0; r < 2; ++r) { const int kg = gk + 16 * r;
        if (kg < 24) { u32x4 va, vb;
            va.x = (vv[r][0] & 0xffffu) | (vv[r][1] << 16); va.y = (vv[r][2] & 0xffffu) | (vv[r][3] << 16); va.z = (vv[r][4] & 0xffffu) | (vv[r][5] << 16); va.w = (vv[r][6] & 0xffffu) | (vv[r][7] << 16);
            vb.x = (vv[r][0] >> 16) | (vv[r][1] & 0xffff0000u); vb.y = (vv[r][2] >> 16) | (vv[r][3] & 0xffff0000u); vb.z = (vv[r][4] >> 16) | (vv[r][5] & 0xffff0000u); vb.w = (vv[r][6] >> 16) | (vv[r][7] & 0xffff0000u);
            *(LAS u32x4*)(VTL + (2 * dp) * 400 + kg * 16) = va; *(LAS u32x4*)(VTL + (2 * dp + 1) * 400 + kg * 16) = vb; } }
    lds_barrier();
    f32x4 S[2][12];
#pragma unroll
    for (int kq = 0; kq < 3; ++kq) { bf16x8 xk[4][2];
#pragma unroll
        for (int t = 0; t < 4; ++t)
#pragma unroll
            for (int dk = 0; dk < 2; ++dk) xk[t][dk] = ldsfrag(KL + (16 * (4 * kq + t) + fr) * 144 + (32 * dk + 8 * fq) * 2);
        SB();
#pragma unroll
        for (int t = 0; t < 4; ++t) { S[0][4 * kq + t] = (f32x4){0.f, 0.f, 0.f, 0.f}; S[1][4 * kq + t] = (f32x4){0.f, 0.f, 0.f, 0.f}; }
#pragma unroll
        for (int dk = 0; dk < 2; ++dk)
#pragma unroll
            for (int t = 0; t < 4; ++t) { S[0][4 * kq + t] = mfma16(xk[t][dk], yq[0][dk], S[0][4 * kq + t]); S[1][4 * kq + t] = mfma16(xk[t][dk], yq[1][dk], S[1][4 * kq + t]); }
        SB(); }
    const float slope = exp2f(-(float)(hh + 1)), sink = sinks[hh];
    float inv[2];
#pragma unroll
    for (int qt = 0; qt < 2; ++qt) { const int tq = tq0 + 16 * qt + fr; float m = sink;
#pragma unroll
        for (int kt = 0; kt < 12; ++kt)
#pragma unroll
            for (int i = 0; i < 4; ++i) { const int j = 16 * kt + 4 * fq + i; const bool ok = SAMPLE ? (j < 144) : (c - 2 + (kt >> 2) >= 0);
                float s = S[qt][kt][i] * 0.125f - slope * fabsf((float)(128 + tq - j)); s = ok ? s : -1e30f; S[qt][kt][i] = s; m = fmaxf(m, s); }
        m = fmaxf(m, __shfl_xor(m, 16)); m = fmaxf(m, __shfl_xor(m, 32));
        float l = 0.f;
#pragma unroll
        for (int kt = 0; kt < 12; ++kt)
#pragma unroll
            for (int i = 0; i < 4; ++i) { const float p = __expf(S[qt][kt][i] - m); S[qt][kt][i] = p; l += p; }
        l += __shfl_xor(l, 16); l += __shfl_xor(l, 32); l += __expf(sink - m);
        inv[qt] = 1.0f / l; }
    f32x4 O[2][4];
#pragma unroll
    for (int qt = 0; qt < 2; ++qt)
#pragma unroll
        for (int dt = 0; dt < 4; ++dt) O[qt][dt] = (f32x4){0.f, 0.f, 0.f, 0.f};
#pragma unroll
    for (int kk = 0; kk < 6; ++kk) { bf16x8 yp[2];
#pragma unroll
        for (int qt = 0; qt < 2; ++qt) yp[qt] = mk8(pkbf(S[qt][2 * kk][0], S[qt][2 * kk][1]), pkbf(S[qt][2 * kk][2], S[qt][2 * kk][3]), pkbf(S[qt][2 * kk + 1][0], S[qt][2 * kk + 1][1]), pkbf(S[qt][2 * kk + 1][2], S[qt][2 * kk + 1][3]));
        u32x2 vlo[4], vhi[4];
#pragma unroll
        for (int dt = 0; dt < 4; ++dt) { const LAS unsigned char* vp = VTL + (16 * dt + fr) * 400 + (32 * kk + 4 * fq) * 2; vlo[dt] = *(const LAS u32x2*)vp; vhi[dt] = *(const LAS u32x2*)(vp + 32); }
        SB();
#pragma unroll
        for (int dt = 0; dt < 4; ++dt) { const bf16x8 xv = mk8(vlo[dt].x, vlo[dt].y, vhi[dt].x, vhi[dt].y);
            O[0][dt] = mfma16(xv, yp[0], O[0][dt]); O[1][dt] = mfma16(xv, yp[1], O[1][dt]); }
        SB(); }
#pragma unroll
    for (int qt = 0; qt < 2; ++qt) { const bool st = SAMPLE ? ((w & 1) == 0 && qt == 0) : true;
        if (st) {
#pragma unroll
            for (int dt = 0; dt < 4; ++dt) *(u32x2*)(MIX + qrow[qt] * DM + 512 + hk * 256 + g * 64 + 16 * dt + 4 * fq) = (u32x2){pkbf(O[qt][dt][0] * inv[qt], O[qt][dt][1] * inv[qt]), pkbf(O[qt][dt][2] * inv[qt], O[qt][dt][3] * inv[qt])}; } }
    lds_barrier();
}

typedef float f32x16 __attribute__((ext_vector_type(16)));
__device__ __forceinline__ f32x16 mfma32(bf16x8 x, bf16x8 y, f32x16 c) { return __builtin_amdgcn_mfma_f32_32x32x16_bf16(x, y, c, 0, 0, 0); }
constexpr int MA_K = 0, MA_KS = 272, MA_VT = 34816, MA_VS = 264;
constexpr int MA_NU_P = (MP / 256) * 4, MA_NU = MA_NU_P + SBATCH * 4;
__device__ __forceinline__ void memattn_phase(const bf16_t* __restrict__ Q, const bf16_t* __restrict__ MKB, const bf16_t* __restrict__ MVB, bf16_t* __restrict__ OB, LAS unsigned char* lds, int bx, int G) {
    const int tid = fresh_tid(), lane = tid & 63, w = __builtin_amdgcn_readfirstlane(tid >> 6), l31 = lane & 31, hi = lane >> 5;
    LAS unsigned char* KB = lds + MA_K; LAS unsigned char* VTB = lds + MA_VT;
    const int kkey = tid >> 4, kc16 = tid & 15;
    const int vdp = tid & 63, vg = tid >> 6;
    u32x4 kreg[4]; unsigned vreg[16];
#define MA_UNIT(u_, qrow_, memrow0_, h_, smp_) do { if ((u_) < MA_NU_P) { const int bh_ = (u_) >> 3, rt_ = (u_) & 7; qrow_ = (bh_ >> 2) * SEQ + rt_ * 256 + 32 * w + l31; memrow0_ = (bh_ >> 2) * MEMT; h_ = bh_ & 3; smp_ = false; } \
        else { const int bs_ = ((u_) - MA_NU_P) >> 2; qrow_ = MP + bs_ * SSEQ + (l31 & 15); memrow0_ = MEMROWS_P + bs_ * MEMT; h_ = ((u_) - MA_NU_P) & 3; smp_ = true; } } while (0)
#define MA_LOADK(memrow0_, h_, st_) do { const unsigned o_ = (unsigned)((memrow0_) + 128 * ((st_) & 1) + kkey) * DM + (h_) * 256 + 128 * ((st_) >> 1) + kc16 * 8; \
        _Pragma("unroll") for (int it = 0; it < 4; ++it) kreg[it] = *(const u32x4*)(MKB + (o_ + (unsigned)(32 * it * DM))); } while (0)
#define MA_LOADV(memrow0_, h_, st_) do { const unsigned o_ = (unsigned)((memrow0_) + 128 * ((st_) & 1) + 8 * vg) * DM + (h_) * 256 + 128 * ((st_) >> 1) + 2 * vdp; \
        _Pragma("unroll") for (int r = 0; r < 2; ++r) _Pragma("unroll") for (int i = 0; i < 8; ++i) vreg[8 * r + i] = *(const unsigned*)(MVB + (o_ + (unsigned)((64 * r + i) * DM))); } while (0)
    int u = (G % 8 == 0) ? (bx & 7) * (G >> 3) + (bx >> 3) : bx;
    if (u >= MA_NU) return;
    int qrow, memrow0, h; bool smp;
    MA_UNIT(u, qrow, memrow0, h, smp);
    MA_LOADK(memrow0, h, 0);
    for (;;) {
        f32x16 S[8];
        bf16x8 yq[8];
#pragma unroll
        for (int st = 0; st < 4; ++st) { const int dh = st >> 1, kb2 = st & 1;
            if (kb2 == 0) {
#pragma unroll
                for (int dk = 0; dk < 8; ++dk) yq[dk] = *(const bf16x8*)(Q + ((unsigned)qrow * DM + (unsigned)(h * 256 + 128 * dh + 16 * dk + 8 * hi))); }
#pragma unroll
            for (int it = 0; it < 4; ++it) *(LAS u32x4*)(KB + (32 * it + kkey) * MA_KS + kc16 * 16) = kreg[it];
            if (st < 3) MA_LOADK(memrow0, h, st + 1); else MA_LOADV(memrow0, h, 0);
            lds_barrier();
            if (dh == 0) {
#pragma unroll
                for (int t4 = 0; t4 < 4; ++t4)
#pragma unroll
                    for (int r = 0; r < 16; ++r) S[4 * kb2 + t4][r] = 0.f; }
#pragma unroll
            for (int tp = 0; tp < 2; ++tp)
#pragma unroll
                for (int dg = 0; dg < 4; ++dg) { bf16x8 kf[2][2];
#pragma unroll
                    for (int t = 0; t < 2; ++t)
#pragma unroll
                        for (int d2 = 0; d2 < 2; ++d2) kf[t][d2] = ldsfrag(KB + (32 * (2 * tp + t) + l31) * MA_KS + (16 * (2 * dg + d2) + 8 * hi) * 2);
                    SB();
#pragma unroll
                    for (int d2 = 0; d2 < 2; ++d2)
#pragma unroll
                        for (int t = 0; t < 2; ++t) S[4 * kb2 + 2 * tp + t] = mfma32(kf[t][d2], yq[2 * dg + d2], S[4 * kb2 + 2 * tp + t]);
                    SB(); }
            lds_barrier();
        }
        float m = -1e30f;
#pragma unroll
        for (int t = 0; t < 8; ++t)
#pragma unroll
            for (int r = 0; r < 16; ++r) m = fmaxf(m, S[t][r]);
        m = fmaxf(m, __shfl_xor(m, 32));
        float l = 0.f; unsigned Pk[8][8];
#pragma unroll
        for (int t = 0; t < 8; ++t)
#pragma unroll
            for (int r = 0; r < 16; r += 2) { const float p0 = __expf(S[t][r] - m), p1 = __expf(S[t][r + 1] - m); l += p0 + p1; Pk[t][r >> 1] = pkbf(p0, p1); }
        l += __shfl_xor(l, 32);
        const float inv = 1.0f / l;
        const int un = u + G; const bool has_next = un < MA_NU;
        int nqrow = 0, nm0 = 0, nh = 0; bool nsmp = false;
        if (has_next) MA_UNIT(un, nqrow, nm0, nh, nsmp);
        f32x16 O[4];
#pragma unroll
        for (int st = 0; st < 4; ++st) { const int dh = st >> 1, kb2 = st & 1;
            if (kb2 == 0) {
#pragma unroll
                for (int dt = 0; dt < 4; ++dt)
#pragma unroll
                    for (int r = 0; r < 16; ++r) O[dt][r] = 0.f; }
#pragma unroll
            for (int r = 0; r < 2; ++r) { unsigned vv[8]; _Pragma("unroll") for (int i = 0; i < 8; ++i) vv[i] = vreg[8 * r + i]; const int kg = vg + 8 * r;
                LAS unsigned char* pa = VTB + (2 * vdp) * MA_VS + kg * 16; LAS unsigned char* pb = pa + MA_VS;
                *(LAS u32x2*)pa = (u32x2){(vv[0] & 0xffffu) | (vv[1] << 16), (vv[2] & 0xffffu) | (vv[3] << 16)}; *(LAS u32x2*)(pa + 8) = (u32x2){(vv[4] & 0xffffu) | (vv[5] << 16), (vv[6] & 0xffffu) | (vv[7] << 16)};
                *(LAS u32x2*)pb = (u32x2){(vv[0] >> 16) | (vv[1] & 0xffff0000u), (vv[2] >> 16) | (vv[3] & 0xffff0000u)}; *(LAS u32x2*)(pb + 8) = (u32x2){(vv[4] >> 16) | (vv[5] & 0xffff0000u), (vv[6] >> 16) | (vv[7] & 0xffff0000u)}; }
            if (st < 3) MA_LOADV(memrow0, h, st + 1); else if (has_next) MA_LOADK(nm0, nh, 0);
            lds_barrier();
#pragma unroll
            for (int t4 = 0; t4 < 4; ++t4) { const int T = 4 * kb2 + t4;
                u32x2 vlo[2][4], vhh[2][4];
#pragma unroll
                for (int k2 = 0; k2 < 2; ++k2)
#pragma unroll
                    for (int dt = 0; dt < 4; ++dt) { const LAS unsigned char* vp = VTB + (32 * dt + l31) * MA_VS + (32 * t4 + 16 * k2 + 4 * hi) * 2;
                        vlo[k2][dt] = *(const LAS u32x2*)vp; vhh[k2][dt] = *(const LAS u32x2*)(vp + 16); }
                SB();
#pragma unroll
                for (int k2 = 0; k2 < 2; ++k2) { const bf16x8 yp = mk8(Pk[T][4 * k2], Pk[T][4 * k2 + 1], Pk[T][4 * k2 + 2], Pk[T][4 * k2 + 3]);
#pragma unroll
                    for (int dt = 0; dt < 4; ++dt) O[dt] = mfma32(mk8(vlo[k2][dt].x, vlo[k2][dt].y, vhh[k2][dt].x, vhh[k2][dt].y), yp, O[dt]); }
                SB(); }
            lds_barrier();
            if (kb2 == 1 && (!smp || (w == 0 && l31 < 16))) {
#pragma unroll
                for (int dt = 0; dt < 4; ++dt)
#pragma unroll
                    for (int rg = 0; rg < 4; ++rg) *(u32x2*)(OB + (size_t)qrow * DM + h * 256 + 128 * dh + 32 * dt + 8 * rg + 4 * hi) =
                        (u32x2){pkbf(O[dt][4 * rg] * inv, O[dt][4 * rg + 1] * inv), pkbf(O[dt][4 * rg + 2] * inv, O[dt][4 * rg + 3] * inv)};
            }
        }
        if (!has_next) break;
        u = un; qrow = nqrow; memrow0 = nm0; h = nh; smp = nsmp;
    }
#undef MA_UNIT
#undef MA_LOADK
#undef MA_LOADV
}

template <int NB, int K, class Epi>
__device__ __forceinline__ void skinny_phase(const bf16_t* __restrict__ A, const bf16_t* __restrict__ Bt, int ntasks, LAS unsigned char* lds, int bx, int G, const Epi& E) {
    const int tid = fresh_tid(), lane = tid & 63, w = __builtin_amdgcn_readfirstlane(tid >> 6), fr = lane & 15, fq = lane >> 4;
    constexpr int kw = K / 8, NS = kw / 32;
    const int k0 = w * kw;
    LAS f32x4* red = (LAS f32x4*)lds;
    for (int t = bx; t < 4 * ntasks; t += G) {
        const int ct = t >> 2, rg = t & 3;
        f32x4 fin[NB];
#pragma unroll
        for (int nb = 0; nb < NB; ++nb) {
            const bf16_t* bp = Bt + (size_t)(E.brow(ct, nb) + fr) * K + k0 + 8 * fq;
            const bf16_t* ap = A + (size_t)(32 * rg + fr) * K + k0 + 8 * fq;
            bf16x8 xb[NS], ya[NS][2];
#pragma unroll
            for (int ks = 0; ks < NS; ++ks) { xb[ks] = *(const bf16x8*)(bp + 32 * ks); ya[ks][0] = *(const bf16x8*)(ap + 32 * ks); ya[ks][1] = *(const bf16x8*)(ap + (size_t)16 * K + 32 * ks); }
            f32x4 acc[2]; acc[0] = (f32x4){0.f, 0.f, 0.f, 0.f}; acc[1] = acc[0];
#pragma unroll
            for (int ks = 0; ks < NS; ++ks) { acc[0] = mfma16(xb[ks], ya[ks][0], acc[0]); acc[1] = mfma16(xb[ks], ya[ks][1], acc[1]); }
            red[(w * 2 + 0) * 64 + lane] = acc[0]; red[(w * 2 + 1) * 64 + lane] = acc[1];
            lds_barrier();
            f32x4 sum = (f32x4){0.f, 0.f, 0.f, 0.f};
            if (w < 2) {
#pragma unroll
                for (int ww = 0; ww < 8; ++ww) sum += red[(ww * 2 + w) * 64 + lane]; }
            fin[nb] = sum;
            lds_barrier();
        }
        if (w < 2) E.tile(ct, 32 * rg + 16 * w + fr, 4 * fq, fin);
    }
}
struct SkZ {
    bf16_t* Z; float* out;
    __device__ __forceinline__ int brow(int t, int) const { return 16 * t; }
    __device__ __forceinline__ void tile(int t, int m, int c4, const f32x4 (&v)[1]) const { const int n = 16 * t + c4; f32x4 x = v[0];
        if (n < 512 || (n >= ZC_HG && n < ZC_AQ)) {
#pragma unroll
            for (int e = 0; e < 4; ++e) x[e] = pg8::silu_f(x[e]); }
        *(u32x2*)(Z + (size_t)(MP + m) * INC + n) = (u32x2){pkbf(x[0], x[1]), pkbf(x[2], x[3])};
        if (n >= ZC_AK) { float* d = out + (n >= ZC_AV ? OFF_VS + (size_t)m * 128 + (n - ZC_AV) : OFF_KS + (size_t)m * 128 + (n - ZC_AK)); *(f32x4*)d = x; } }
};
struct SkRes {
    bf16_t* XPRE; const bf16_t* XB; const float* xs;
    __device__ __forceinline__ int brow(int t, int) const { return 16 * t; }
    __device__ __forceinline__ void tile(int t, int m, int c4, const f32x4 (&v)[1]) const { const int n = 16 * t + c4; f32x4 r;
        if (xs) r = *(const f32x4*)(xs + (size_t)m * DM + n);
        else { const u32x2 q = *(const u32x2*)(XB + (size_t)(MP + m) * DM + n); r = (f32x4){bflo(q.x), bfhi(q.x), bflo(q.y), bfhi(q.y)}; }
        const f32x4 y = r * ALPHA + v[0];
        st8_wt(XPRE + (size_t)(MP + m) * DM + n, (u32x2){pkbf(y[0], y[1]), pkbf(y[2], y[3])}); }
};
struct SkQ {
    bf16_t* O; float scale;
    __device__ __forceinline__ int brow(int t, int) const { return 16 * t; }
    __device__ __forceinline__ void tile(int t, int m, int c4, const f32x4 (&v)[1]) const { const f32x4 y = v[0] * scale;
        *(u32x2*)(O + (size_t)(MP + m) * DM + 16 * t + c4) = (u32x2){pkbf(y[0], y[1]), pkbf(y[2], y[3])}; }
};
struct SkSwiglu {
    bf16_t* H;
    __device__ __forceinline__ int brow(int t, int nb) const { const int j = 16 * t; return 256 * (j >> 7) + (j & 127) + 128 * nb; }
    __device__ __forceinline__ void tile(int t, int m, int c4, const f32x4 (&v)[2]) const {
        *(u32x2*)(H + (size_t)(MP + m) * DFF + 16 * t + c4) = (u32x2){pkbf(pg8::silu_f(v[0][0]) * v[1][0], pg8::silu_f(v[0][1]) * v[1][1]), pkbf(pg8::silu_f(v[0][2]) * v[1][2], pg8::silu_f(v[0][3]) * v[1][3])}; }
};

template <int MODE>
__device__ __forceinline__ void skinny_batch_phase(const bf16_t* __restrict__ A, const bf16_t* __restrict__ Bt, bf16_t* __restrict__ Pst, float* __restrict__ LSUM, bf16_t* __restrict__ XPRE, const bf16_t* __restrict__ XB,
                                                   LAS unsigned char* lds, int bx, int G) {
    const int tid = fresh_tid(), lane = tid & 63, w = __builtin_amdgcn_readfirstlane(tid >> 6), fr = lane & 15, fq = lane >> 4;
    LAS f32x4* red = (LAS f32x4*)lds;
    for (int t = bx; t < SBATCH * 64; t += G) {
        const int bs = t >> 6, ct = t & 63;
        const bf16_t* bp = Bt + ((size_t)(NBATCH + bs) * DM + 16 * ct + fr) * DM + 128 * w + 8 * fq;
        const bf16_t* ap = A + (size_t)(MP + bs * SSEQ + fr) * DM + 128 * w + 8 * fq;
        bf16x8 xb[4], ya[4];
#pragma unroll
        for (int ks = 0; ks < 4; ++ks) { xb[ks] = *(const bf16x8*)(bp + 32 * ks); ya[ks] = *(const bf16x8*)(ap + 32 * ks); }
        f32x4 acc = (f32x4){0.f, 0.f, 0.f, 0.f};
#pragma unroll
        for (int ks = 0; ks < 4; ++ks) acc = mfma16(xb[ks], ya[ks], acc);
        if (MODE == 1) acc = acc * (1.0f / LSUM[(bs * SSEQ + fr) * 4 + (w >> 1)]);
        red[w * 64 + lane] = acc;
        lds_barrier();
        if (w == 0) { f32x4 v = (f32x4){0.f, 0.f, 0.f, 0.f};
#pragma unroll
            for (int ww = 0; ww < 8; ++ww) v += red[ww * 64 + lane];
            const size_t row = (size_t)(MP + bs * SSEQ + fr); const int n = 16 * ct + 4 * fq;
            if (MODE == 0) {
#pragma unroll
                for (int e = 0; e < 4; ++e) v[e] = __expf(v[e]);
                *(u32x2*)(Pst + row * DM + n) = (u32x2){pkbf(v[0], v[1]), pkbf(v[2], v[3])};
                float sm = (v[0] + v[1]) + (v[2] + v[3]); sm += __shfl_xor(sm, 16); sm += __shfl_xor(sm, 32);
                if (fq == 0) atomicAdd(LSUM + (bs * SSEQ + fr) * 4 + (ct >> 4), sm);
            } else { const u32x2 q = *(const u32x2*)(XB + row * DM + n); const f32x4 r = (f32x4){bflo(q.x), bfhi(q.x), bflo(q.y), bfhi(q.y)};
                const f32x4 y = r * ALPHA + v; *(u32x2*)(XPRE + row * DM + n) = (u32x2){pkbf(y[0], y[1]), pkbf(y[2], y[3])}; } }
        lds_barrier();
    }
}

template <int FINAL, int WT = 0>
__device__ __forceinline__ void ln_rows(const bf16_t* __restrict__ XPRE, bf16_t* __restrict__ XB, const float* __restrict__ g, const float* __restrict__ bt, float* __restrict__ out, int gw, int ngw, int lane, int rbeg) {
    f32x4 gv[4], bv[4];
#pragma unroll
    for (int j = 0; j < 4; ++j) { const int e = 512 * (j >> 1) + 8 * lane + 4 * (j & 1); gv[j] = *(const f32x4*)(g + e); bv[j] = *(const f32x4*)(bt + e); }
    const int nrows = MP + MS;
    for (int row = rbeg + gw; row < nrows; row += ngw) {
        const bf16_t* xr = XPRE + (size_t)row * DM + 8 * lane;
        const u32x4 w0 = *(const u32x4*)xr, w1 = *(const u32x4*)(xr + 512);
        f32x4 v[4];
        v[0] = (f32x4){bflo(w0.x), bfhi(w0.x), bflo(w0.y), bfhi(w0.y)}; v[1] = (f32x4){bflo(w0.z), bfhi(w0.z), bflo(w0.w), bfhi(w0.w)};
        v[2] = (f32x4){bflo(w1.x), bfhi(w1.x), bflo(w1.y), bfhi(w1.y)}; v[3] = (f32x4){bflo(w1.z), bfhi(w1.z), bflo(w1.w), bfhi(w1.w)};
        float s = 0.f;
#pragma unroll
        for (int j = 0; j < 4; ++j) s += (v[j][0] + v[j][1]) + (v[j][2] + v[j][3]);
#pragma unroll
        for (int o = 1; o < 64; o <<= 1) s += __shfl_xor(s, o);
        const float mean = s * (1.0f / DM); float s2 = 0.f;
#pragma unroll
        for (int j = 0; j < 4; ++j) { v[j] = v[j] - mean; s2 += (v[j][0] * v[j][0] + v[j][1] * v[j][1]) + (v[j][2] * v[j][2] + v[j][3] * v[j][3]); }
#pragma unroll
        for (int o = 1; o < 64; o <<= 1) s2 += __shfl_xor(s2, o);
        const float rstd = rsqrtf(s2 * (1.0f / DM) + LN_EPS);
#pragma unroll
        for (int j = 0; j < 4; ++j) v[j] = v[j] * rstd * gv[j] + bv[j];
        if (FINAL) { float* orow = ((row < MP) ? out + OFF_YP + (size_t)row * DM : out + OFF_YS + (size_t)(row - MP) * DM) + 8 * lane;
            *(f32x4*)orow = v[0]; *(f32x4*)(orow + 4) = v[1]; *(f32x4*)(orow + 512) = v[2]; *(f32x4*)(orow + 516) = v[3];
        } else { bf16_t* orow = XB + (size_t)row * DM + 8 * lane;
            if (WT) { st8_wt(orow, (u32x2){pkbf(v[0][0], v[0][1]), pkbf(v[0][2], v[0][3])}); st8_wt(orow + 4, (u32x2){pkbf(v[1][0], v[1][1]), pkbf(v[1][2], v[1][3])});
                      st8_wt(orow + 512, (u32x2){pkbf(v[2][0], v[2][1]), pkbf(v[2][2], v[2][3])}); st8_wt(orow + 516, (u32x2){pkbf(v[3][0], v[3][1]), pkbf(v[3][2], v[3][3])}); }
            else {
            *(u32x4*)orow = (u32x4){pkbf(v[0][0], v[0][1]), pkbf(v[0][2], v[0][3]), pkbf(v[1][0], v[1][1]), pkbf(v[1][2], v[1][3])};
            *(u32x4*)(orow + 512) = (u32x4){pkbf(v[2][0], v[2][1]), pkbf(v[2][2], v[2][3]), pkbf(v[3][0], v[3][1]), pkbf(v[3][2], v[3][3])}; } }
    }
}

#define GAS __attribute__((address_space(1)))

typedef GAS unsigned gu32;
typedef GAS unsigned long long gu64;
#define RLX_AGENT __ATOMIC_RELAXED, __HIP_MEMORY_SCOPE_AGENT
#define XB_TMO      128
#define XB_XCNT(j)  (256  + 64 * (j))
#define XB_XSUB(j)  (1280 + 64 * (j))
#define XB_XGEN(j)  (2304 + 64 * (j))
#define XB_TOP      3328
#define XB_TOPGEN   3392
#define XCD_BAR_WORDS 3456
#define XB_SPIN_CAP (1u << 18)

__device__ __forceinline__ unsigned xb_ld(unsigned* p)              { return __hip_atomic_load(p, __ATOMIC_RELAXED, __HIP_MEMORY_SCOPE_AGENT); }
__device__ __forceinline__ unsigned xb_add(unsigned* p, unsigned v) { return __hip_atomic_fetch_add(p, v, __ATOMIC_RELAXED, __HIP_MEMORY_SCOPE_AGENT); }
__device__ __forceinline__ unsigned xb_xcc_id() { return (unsigned)__builtin_amdgcn_s_getreg((3 << 11) | 20) & 0xFu; }
#define XB_SPIN(cond, bar) do { unsigned _sp = 0; while (cond) { __builtin_amdgcn_s_sleep(1); \
    if ((++_sp & 255u) == 0u) { if (xb_ld(&(bar)[XB_TMO])) break; if (_sp > XB_SPIN_CAP) { atomicAdd(&(bar)[XB_TMO], 1u); break; } } } } while (0)

struct XcdBarrier {
    unsigned* bar; unsigned x;
    volatile LAS unsigned* st;
};

__device__ __forceinline__ XcdBarrier xcd_barrier_post(unsigned* bar, volatile LAS unsigned* st) {
    XcdBarrier b; b.bar = bar; b.x = xb_xcc_id(); b.st = st;
    if (threadIdx.x == 0) (void)xb_add(&bar[XB_XCNT(b.x)], 1u);
    return b;
}
__device__ __forceinline__ void xcd_barrier_complete(unsigned* bar, unsigned x, unsigned& nloc, unsigned& nx) {
    const unsigned G = gridDim.x * gridDim.y * gridDim.z;
    unsigned sum, cnt, mine, sp = 0u;
    for (;;) {
        sum = 0u; cnt = 0u; mine = 0u;
#pragma unroll
        for (unsigned j = 0; j < 16; ++j) { const unsigned c = xb_ld(&bar[XB_XCNT(j)]); sum += c; cnt += (c > 0u) ? 1u : 0u; mine = (j == x) ? c : mine; }
        if (sum == G) break;
        __builtin_amdgcn_s_sleep(1);
        if ((++sp & 255u) == 0u) { if (xb_ld(&bar[XB_TMO])) break; if (sp > XB_SPIN_CAP) { atomicAdd(&bar[XB_TMO], 1u); break; } }
    }
    nloc = mine > 0u ? mine : 1u; nx = cnt > 0u ? cnt : 1u;
}

__device__ __forceinline__ void xcd_barrier(const XcdBarrier& b) {
    asm volatile("s_waitcnt vmcnt(0)" ::: "memory");
    __syncthreads();
    if (threadIdx.x == 0) {
        unsigned* bar = b.bar;
        __builtin_amdgcn_s_waitcnt(0);
        unsigned nloc = b.st[0], nx = b.st[1];
        if (nloc == 0u) { xcd_barrier_complete(bar, b.x, nloc, nx); b.st[0] = nloc; b.st[1] = nx; }
        const unsigned old = xb_add(&bar[XB_XSUB(b.x)], 1u);
        const unsigned gen = old / nloc;
        if (old + 1u == (gen + 1u) * nloc) {
            __builtin_amdgcn_fence(__ATOMIC_RELEASE, "agent");
            asm volatile("s_waitcnt vmcnt(0)" ::: "memory");
            const unsigned og = xb_add(&bar[XB_TOP], 1u);
            const unsigned tg = og / nx;
            if (og + 1u == (tg + 1u) * nx) xb_add(&bar[XB_TOPGEN], 1u);
            else XB_SPIN(xb_ld(&bar[XB_TOPGEN]) == tg, bar);
            __builtin_amdgcn_fence(__ATOMIC_ACQUIRE, "agent");
            xb_add(&bar[XB_XGEN(b.x)], 1u);
            asm volatile("s_waitcnt vmcnt(0)" ::: "memory");
        } else {
            XB_SPIN(xb_ld(&bar[XB_XGEN(b.x)]) == gen, bar);
            __builtin_amdgcn_fence(__ATOMIC_ACQUIRE, "agent");
            asm volatile("s_waitcnt vmcnt(0)" ::: "memory");
        }
    }
    __syncthreads();
}

__device__ __forceinline__ void flag_arrive(unsigned* cnt) { __threadfence(); __syncthreads(); if (threadIdx.x == 0) __hip_atomic_fetch_add(cnt, 1u, __ATOMIC_RELAXED, __HIP_MEMORY_SCOPE_AGENT); }
__device__ __forceinline__ void flag_arrive_wt(unsigned* cnt) { asm volatile("s_waitcnt vmcnt(0)" ::: "memory"); __syncthreads(); if (threadIdx.x == 0) __hip_atomic_fetch_add(cnt, 1u, __ATOMIC_RELAXED, __HIP_MEMORY_SCOPE_AGENT); }
__device__ __forceinline__ void flag_wait(unsigned* cnt, unsigned target) {
    if (threadIdx.x == 0) {
        for (unsigned sp = 0; sp < (1u << 22); ++sp) { if (__hip_atomic_load(cnt, __ATOMIC_RELAXED, __HIP_MEMORY_SCOPE_AGENT) >= target) break; __builtin_amdgcn_s_sleep(2); }
        __builtin_amdgcn_fence(__ATOMIC_ACQUIRE, "agent"); asm volatile("s_waitcnt vmcnt(0)" ::: "memory"); }
    __syncthreads();
}
#ifndef REP_G
#define REP_G 1
#endif
#ifndef REP_L
#define REP_L 1
#endif
constexpr int LDS_XL = 131072 + 256;
#ifndef FUSE_LN
#define FUSE_LN 1
#endif
constexpr int LDS_BYTES = 131072 + 256 + 10240 + 256;
constexpr int CW_BAR = 1024;
constexpr bool kALIGN = true, kSP2 = true;
__global__ void __launch_bounds__(512, 2) fwd_kernel(Params P) {
    extern __shared__ __attribute__((aligned(16))) unsigned char lds_raw[];
    LAS unsigned char* lds = (LAS unsigned char*)lds_raw;
    cg::grid_group grid = cg::this_grid();
    const int G = gridDim.x, bx = blockIdx.x;
    const int ngw = G * 8;
    const size_t nt = (size_t)G * 512;
#define FRESH_IDS() const int tid = fresh_tid(), lane = tid & 63, wave = __builtin_amdgcn_readfirstlane(tid >> 6), gw = bx * 8 + wave; const size_t gt = (size_t)bx * 512 + tid; (void)lane; (void)gw; (void)gt
    unsigned char* ws = P.ws; float* out = P.out;
    unsigned* ctl = (unsigned*)(ws + WS_CTL);
    bf16_t* WinT = (bf16_t*)(ws + WS_WIN); bf16_t* WoutT = (bf16_t*)(ws + WS_WOUT); bf16_t* WqN = (bf16_t*)(ws + WS_WQ); bf16_t* WkvT = (bf16_t*)(ws + WS_WKV);
    bf16_t* WoT = (bf16_t*)(ws + WS_WO); bf16_t* Wf1T = (bf16_t*)(ws + WS_WF1); bf16_t* Wf2T = (bf16_t*)(ws + WS_WF2);
    bf16_t* XB = (bf16_t*)(ws + WS_XB); bf16_t* Z = (bf16_t*)(ws + WS_Z); bf16_t* MIX = (bf16_t*)(ws + WS_MIX); bf16_t* XPRE = (bf16_t*)(ws + WS_XPRE);
    bf16_t* WPT = (bf16_t*)(ws + WS_WPT); bf16_t* VPT = (bf16_t*)(ws + WS_VPT); float* LSUM = (float*)(ws + WS_CTL + 32768);
    bf16_t* MEMB = (bf16_t*)(ws + WS_MEMB); bf16_t* MKB = (bf16_t*)(ws + WS_MKB); bf16_t* MVB = (bf16_t*)(ws + WS_MVB);
    const float* x_prompt = P.in[0]; const float* x_sample = P.in[1];

    if (threadIdx.x < 64) ((LAS unsigned*)(lds + 131072))[threadIdx.x] = 0u;
    __syncthreads();
    if (P.ws == nullptr) grid.sync();
    const XcdBarrier bar = xcd_barrier_post((unsigned*)(P.ws + WS_CTL) + CW_BAR, (volatile LAS unsigned*)(lds + 131072 + 64));
    for (int rl = 0; rl < REP_L; ++rl) {
        FRESH_IDS();
        for (size_t i = gt; i < (size_t)3 * MP * 4 / 2; i += nt) ((u32x4*)(ws + WS_XCH))[i] = (u32x4){~0u, ~0u, ~0u, ~0u};
        LAS float* scr = (LAS float*)(lds + wave * 16384);
        constexpr int I_IN = 16 * 88, I_SQ = 16 * 32, I_KV = 16 * 64, I_F1 = 16 * 176, I_F2 = 44 * 32;
        constexpr int NIT = I_IN + 2 * I_SQ + I_KV + I_F1 + I_F2;
        for (int it = gw; it < NIT; it += ngw) { int r = it;
            if (r < I_IN) { transpose_item(P.in[8], DM, INC, WinT, scr, r, lane, 0); continue; } r -= I_IN;
            if (r < I_SQ) { transpose_item(P.in[12], DM, DM, WoutT, scr, r, lane, 0); continue; } r -= I_SQ;
            if (r < I_KV) { transpose_item(P.in[14], DM, 2 * DM, WkvT, scr, r, lane, 0); continue; } r -= I_KV;
            if (r < I_SQ) { transpose_item(P.in[15], DM, DM, WoT, scr, r, lane, 0); continue; } r -= I_SQ;
            if (r < I_F1) { transpose_item(P.in[16], DM, 2 * DFF, Wf1T, scr, r, lane, 1); continue; } r -= I_F1;
            transpose_item(P.in[17], DFF, DM, Wf2T, scr, r, lane, 0);
        }
        cvt_copy(x_prompt, XB, (size_t)MP * DM / 8, gt, nt);
        cvt_copy(x_sample, XB + (size_t)MP * DM, (size_t)MS * DM / 8, gt, nt);
        zero16(XB + (size_t)(MP + MS) * DM, (size_t)(MT - MP - MS) * DM * 2 / 16, gt, nt);
        zero16(MIX + (size_t)(MP + MS) * DM, (size_t)(MT - MP - MS) * DM * 2 / 16, gt, nt);
        cvt_copy(P.in[13], WqN, (size_t)DM * DM / 8, gt, nt);
        cvt_copy(P.in[7], MEMB, (size_t)MEMROWS_P * DM / 8, gt, nt);
        cvt_copy(P.in[5], MKB + (size_t)MEMROWS_P * DM, (size_t)SBATCH * MEMT * DM / 8, gt, nt);
        cvt_copy(P.in[6], MVB + (size_t)MEMROWS_P * DM, (size_t)SBATCH * MEMT * DM / 8, gt, nt);
    }
    xcd_barrier(bar);
    for (int rg = 0; rg < REP_G; ++rg) {
        { pg8::Gemm g{XB, WinT, MP, INC, DM, DM, DM, 0}; pg8::StaticOrder S; S.init(MP, INC, G, bx); pg8::EpiZ E{Z, out};
          pg8::gemm_phase<pg8::EpiZ, pg8::StaticOrder, kALIGN, kSP2>(lds, g, S, E); }
        { SkZ E{Z, out}; skinny_phase<1, DM>(XB + (size_t)MP * DM, WinT, INC / 16, lds, bx, G, E); }
    }
    xcd_barrier(bar);
#ifndef REP_P2
#define REP_P2 1
#endif
#ifndef REP_P6
#define REP_P6 1
#endif
    for (int rep = 0; rep < REP_P2; ++rep) {
        if (rep > 0) { xcd_barrier(bar); if (bx == 0 && threadIdx.x == 0) __hip_atomic_store(ctl, 0u, __ATOMIC_RELAXED, __HIP_MEMORY_SCOPE_AGENT); xcd_barrier(bar); }
        if (bx < 128) { const int b = bx >> 2, h = bx & 3;
            hgrn_item<64, SEQ / 64, false>(Z, MIX, P.in[9], P.in[10], nullptr, out + OFF_SP + (size_t)(b * 4 + h) * 16384, lds, b * SEQ, h);
        } else if (bx < 160) { const int b = (bx - 128) >> 2, h = (bx - 128) & 3;
            hgrn_item<SSEQ, 1, true>(Z, MIX, P.in[9], P.in[10], P.in[4] + (size_t)(b * 4 + h) * 16384, out + OFF_SS + (size_t)(b * 4 + h) * 16384, lds, MP + b * SSEQ, h);
        }
        if (bx >= 128 && rep == 0) {
            pg8::Gemm g{MEMB, WkvT, MEMROWS_P, 2 * DM, DM, DM, DM, 0}; pg8::StaticOrder S; S.init(MEMROWS_P, 2 * DM, G - 128, bx - 128); pg8::EpiKV E{MKB, MVB, out};
            pg8::gemm_phase<pg8::EpiKV, pg8::StaticOrder, kALIGN, kSP2>(lds, g, S, E);
        }
        FRESH_IDS();
        LAS int* qslot = (LAS int*)(lds + 131072);
        constexpr int NSW_P = NBATCH * 32 * 2, NSW = NSW_P + SBATCH * 2;
        for (;;) {
            __syncthreads();
            if (tid == 0) *qslot = (int)atomicAdd(ctl, 1u);
            __syncthreads();
            const int it = *qslot;
            if (it >= NSW) break;
            if (it < SBATCH * 2) swa_item<1>(Z, MIX, P.in[2], P.in[3], P.in[11], lds, it >> 1, 0, it & 1);
            else { const int ip = it - SBATCH * 2; swa_item<0>(Z, MIX, P.in[2], P.in[3], P.in[11], lds, ip >> 6, (ip >> 1) & 31, ip & 1); }
        }
    }
    xcd_barrier(bar);
    { pg8::Gemm g{MIX, WoutT, MP, DM, DM, DM, DM, 0}; pg8::StaticOrder S; S.init(MP, DM, G, bx);
      pg8::EpiResLN E{XB, x_prompt, XB, nullptr, P.in[18], P.in[19], (unsigned long long*)(ws + WS_XCH), lds + LDS_XL};
      pg8::gemm_phase<pg8::EpiResLN, pg8::StaticOrder, kALIGN, kSP2>(lds, g, S, E);
      SkRes E2{XPRE, XB, x_sample}; skinny_phase<1, DM>(MIX + (size_t)MP * DM, WoutT, DM / 16, lds, bx, G, E2); }
    int kfold = 256; asm volatile("" : "+s"(kfold));
    { pg8::Gemm g{MKB, WqN, NBT * 4 * 256, DM, kfold, DM, DM, 1}; pg8::StaticOrder S; S.init(NBT * 4 * 256, DM, G, bx); pg8::EpiQ E{WPT, 0.0625f, 0};
      pg8::gemm_phase<pg8::EpiQ, pg8::StaticOrder, kALIGN, kSP2>(lds, g, S, E); }
    { pg8::Gemm g{WoT, MVB, NBT * 4 * 256, DM, kfold, DM, DM, 2}; pg8::StaticOrder S; S.init(NBT * 4 * 256, DM, G, bx); pg8::EpiQ E{VPT, 1.0f, 1};
      pg8::gemm_phase<pg8::EpiQ, pg8::StaticOrder, kALIGN, kSP2>(lds, g, S, E); }
    xcd_barrier(bar);
    if (bx < 16) { { FRESH_IDS(); ln_rows<0, 1>(XPRE, XB, P.in[18], P.in[19], out, gw, ngw, lane, MP); } flag_arrive_wt(ctl + 64); }
    { pg8::Gemm g{XB, WPT, MP, DM, DM, DM, DM, 3}; pg8::StaticOrder S; S.init(MP, DM, G, bx); pg8::EpiSoftmax E{MIX, lds + LDS_XL};
      pg8::gemm_phase<pg8::EpiSoftmax, pg8::StaticOrder, kALIGN, kSP2>(lds, g, S, E);
      flag_wait(ctl + 64, 16u);
      skinny_batch_phase<0>(XB, WPT, MIX, LSUM, XPRE, XB, lds, bx, G); }
    xcd_barrier(bar);
    { pg8::Gemm g{MIX, VPT, MP, DM, DM, DM, DM, 3}; pg8::StaticOrder S; S.init(MP, DM, G, bx);
      pg8::EpiResLN E{XB, nullptr, XB, nullptr, P.in[18] + DM, P.in[19] + DM, (unsigned long long*)(ws + WS_XCH) + (size_t)MP * 4, lds + LDS_XL};
      pg8::gemm_phase<pg8::EpiResLN, pg8::StaticOrder, kALIGN, kSP2>(lds, g, S, E);
      skinny_batch_phase<1>(MIX, VPT, MIX, LSUM, XPRE, XB, lds, bx, G); }
    xcd_barrier(bar);
    if (bx < 16) { { FRESH_IDS(); ln_rows<0, 1>(XPRE, XB, P.in[18] + DM, P.in[19] + DM, out, gw, ngw, lane, MP); } flag_arrive_wt(ctl + 128); }
    for (int rg = 0; rg < REP_G; ++rg)
    { pg8::Gemm g{XB, Wf1T, MP, 2 * DFF, DM, DM, DM, 0}; pg8::StaticOrder S; S.init(MP, 2 * DFF, G, bx); pg8::EpiSwiglu E{Z};
      pg8::gemm_phase<pg8::EpiSwiglu, pg8::StaticOrder, kALIGN, kSP2>(lds, g, S, E);
      flag_wait(ctl + 128, 16u);
      SkSwiglu E2{Z}; skinny_phase<2, DM>(XB + (size_t)MP * DM, Wf1T, DFF / 16, lds, bx, G, E2); }
    xcd_barrier(bar);
    { SkRes E2{XPRE, XB, nullptr}; skinny_phase<1, DFF>(Z + (size_t)MP * DFF, Wf2T, DM / 16, lds, bx, G, E2); flag_arrive_wt(ctl + 192); }
    { pg8::Gemm g{Z, Wf2T, MP, DM, DFF, DFF, DFF, 0}; pg8::StaticOrder S; S.init(MP, DM, G, bx);
      pg8::EpiResLN E{XB, nullptr, nullptr, out + OFF_YP, P.in[18] + 2 * DM, P.in[19] + 2 * DM, (unsigned long long*)(ws + WS_XCH) + (size_t)2 * MP * 4, lds + LDS_XL};
      pg8::gemm_phase<pg8::EpiResLN, pg8::StaticOrder, kALIGN, kSP2>(lds, g, S, E); }
    if (bx < 16) { flag_wait(ctl + 192, (unsigned)G); { FRESH_IDS(); ln_rows<1>(XPRE, XB, P.in[18] + 2 * DM, P.in[19] + 2 * DM, out, gw, ngw, lane, MP); } }
}

extern "C" void kernel_launch(void* const* d_in, const int* in_sizes, int n_in, void* d_out, int out_size, void* d_ws, size_t ws_size, hipStream_t stream) {
    static int grid_blocks = 0;
    if (grid_blocks == 0) {
        if (n_in != 20 || (size_t)out_size != OUT_TOTAL || ws_size < WS_END) { fprintf(stderr, "kernel_launch: unexpected shapes (n_in %d, out %d, ws %zu; need ws >= %zu)\n", n_in, out_size, ws_size, (size_t)WS_END); grid_blocks = -1; return; }
        int dev = 0, cus = 0, per_cu = 0;
        hipGetDevice(&dev);
        hipDeviceGetAttribute(&cus, hipDeviceAttributeMultiprocessorCount, dev);
        if (hipFuncSetAttribute((const void*)fwd_kernel, hipFuncAttributeMaxDynamicSharedMemorySize, LDS_BYTES) != hipSuccess) fprintf(stderr, "kernel_launch: hipFuncSetAttribute failed\n");
        if (hipOccupancyMaxActiveBlocksPerMultiprocessor(&per_cu, (const void*)fwd_kernel, 512, LDS_BYTES) != hipSuccess || per_cu < 1) { fprintf(stderr, "kernel_launch: occupancy query gave %d\n", per_cu); per_cu = 1; }
        (void)hipGetLastError();
        grid_blocks = cus * per_cu;
        if (grid_blocks != 256) { fprintf(stderr, "kernel_launch: built for a 256-workgroup grid (256 CUs x 1), got %d: nothing launched\n", grid_blocks); grid_blocks = -1; return; }
    }
    if (grid_blocks < 0) return;
    if (hipMemsetAsync((char*)d_ws + WS_CTL, 0, 65536, stream) != hipSuccess) { fprintf(stderr, "kernel_launch: hipMemsetAsync failed\n"); return; }
    Params p{};
    for (int i = 0; i < 20; ++i) p.in[i] = (const float*)d_in[i];
    p.out = (float*)d_out; p.ws = (unsigned char*)d_ws;
    void* args[] = {&p};
    hipError_t e = hipLaunchCooperativeKernel((const void*)fwd_kernel, dim3(grid_blocks), dim3(512), args, LDS_BYTES, stream);
    if (e != hipSuccess) fprintf(stderr, "kernel_launch: cooperative launch failed: %s (grid %d)\n", hipGetErrorString(e), grid_blocks);
}
```

```cpp
#include <hip/hip_runtime.h>
#include <hip/hip_cooperative_groups.h>
#include <cstdio>
#include <cstdint>
namespace cg = cooperative_groups;

constexpr int DM = 1024;
constexpr int NBATCH = 32, SEQ = 2048, MP = NBATCH * SEQ;
constexpr int SBATCH = 8, SSEQ = 16, MS = SBATCH * SSEQ;
constexpr int MT = MP + 256;
constexpr int INC = 2816, DFF = 2816, MEMT = 256;
constexpr int MEMROWS_P = NBATCH * MEMT, MEMROWS = MEMROWS_P + SBATCH * MEMT;
constexpr float ALPHA = 1.189207115002721f;
constexpr float LN_EPS = 1e-5f;
constexpr int ZC_HQ = 0, ZC_HF = 512, ZC_HI = 1024, ZC_HG = 1536, ZC_AQ = 2048, ZC_AK = 2560, ZC_AV = 2688;
constexpr size_t OFF_YP = 0, OFF_YS = OFF_YP + (size_t)MP * DM, OFF_KP = OFF_YS + (size_t)MS * DM, OFF_VP = OFF_KP + 32 * 128 * 128,
                 OFF_SP = OFF_VP + 32 * 128 * 128, OFF_MK = OFF_SP + 32 * 4 * 128 * 128, OFF_MV = OFF_MK + (size_t)MEMROWS_P * DM,
                 OFF_KS = OFF_MV + (size_t)MEMROWS_P * DM, OFF_VS = OFF_KS + MS * 128, OFF_SS = OFF_VS + MS * 128, OUT_TOTAL = OFF_SS + 8 * 4 * 128 * 128;
constexpr size_t WS_CTL = 0;
constexpr size_t WS_WIN = 65536;
constexpr size_t WS_WOUT = WS_WIN + (size_t)INC * DM * 2;
constexpr size_t WS_WQ = WS_WOUT + (size_t)DM * DM * 2;
constexpr size_t WS_WKV = WS_WQ + (size_t)DM * DM * 2;
constexpr size_t WS_WO = WS_WKV + (size_t)2 * DM * DM * 2;
constexpr size_t WS_WF1 = WS_WO + (size_t)DM * DM * 2;
constexpr size_t WS_WF2 = WS_WF1 + (size_t)2 * DFF * DM * 2;
constexpr size_t WS_XB = WS_WF2 + (size_t)DFF * DM * 2;
constexpr size_t WS_Z = WS_XB + (size_t)MT * DM * 2;
constexpr size_t WS_MIX = WS_Z + (size_t)MT * INC * 2;
constexpr size_t WS_XPRE = WS_MIX + (size_t)MT * DM * 2;
constexpr size_t WS_MEMB = WS_XPRE + (size_t)MT * DM * 2;
constexpr size_t WS_MKB = WS_MEMB + (size_t)MEMROWS_P * DM * 2;
constexpr size_t WS_MVB = WS_MKB + (size_t)MEMROWS * DM * 2;
constexpr size_t WS_XCH = WS_MVB + (size_t)MEMROWS * DM * 2;
constexpr size_t WS_CNT = WS_XCH + (size_t)3 * MP * 4 * 8;
constexpr int NBT = NBATCH + SBATCH;
constexpr size_t WS_WPT = WS_CNT + (size_t)3 * 256 * 256;
constexpr size_t WS_VPT = WS_WPT + (size_t)NBT * DM * DM * 2;
constexpr size_t WS_END = WS_VPT + (size_t)NBT * DM * DM * 2;
static_assert(WS_END <= (size_t)1073741824, "d_ws map exceeds the guaranteed 1 GiB");
namespace pg8 {
#define PG8_LAS __attribute__((address_space(3)))
typedef unsigned short bf16_t;
typedef short bf16x8 __attribute__((ext_vector_type(8)));
typedef float f32x4 __attribute__((ext_vector_type(4)));
typedef unsigned u32x4 __attribute__((ext_vector_type(4)));
constexpr int BM = 256, BK = 64, HALF = 128, HTB = HALF * BK * 2  , STAGE_BYTES = 8 * HTB, NXCD = 8, WGM = 8;

__host__ __device__ __forceinline__ int lds_byte(int r, int c) { const int st = (r >> 4) * 2 + (c >> 5), rr = r & 15, cc = c & 31, ob = rr * 64 + cc * 2; return st * 1024 + (ob ^ (((ob >> 9) & 1) << 5)); }
__host__ __device__ __forceinline__ void stage_rc(int b, int& R, int& C) { const int st = b / 1024, sb = b % 1024, swz = sb ^ (((sb >> 9) & 1) << 5); R = (st >> 1) * 16 + swz / 64; C = (st & 1) * 32 + (swz % 64) / 2; }
__host__ __device__ __forceinline__ int perm32(int rho) { const int n = rho >> 4, i = rho & 15; return 8 * (i >> 2) + 4 * n + (i & 3); }

struct Unit { int pm, pn; };
struct Gemm { const bf16_t* A; const bf16_t* Bt; int M, N, K, lda, ldb, mode;
    __device__ __forceinline__ size_t aoff(const Unit& u) const {
        if (mode == 1) return ((size_t)(u.pm >> 2) * 256 * lda + (size_t)(u.pm & 3) * 256) * 2;
        if (mode == 2) return ((size_t)(u.pm & 3) * 256 * lda + (size_t)u.pn * 256) * 2;
        return (size_t)u.pm * 256 * lda * 2; }
    __device__ __forceinline__ size_t boff(const Unit& u) const {
        if (mode == 1) return ((size_t)u.pn * 256 * ldb + (size_t)(u.pm & 3) * 256) * 2;
        if (mode == 2) return ((size_t)(u.pm >> 2) * 256 * ldb + (size_t)u.pn * 256) * 2;
        if (mode == 3) return ((size_t)(u.pm >> 3) * 1024 + (size_t)u.pn * 256) * ldb * 2;
        return (size_t)u.pn * 256 * ldb * 2; }
};

struct StaticOrder {
    int nM, nN, nwg, G, c;
    __host__ __device__ void init(int M, int N, int G_, int c_) { nM = M / BM; nN = N / BM; nwg = nM * nN; G = G_; c = c_; }
    __host__ __device__ bool next(int i, Unit& u) const {
        const long L = (long)i * G + c; if (L >= nwg) return false;
        int wgid = (int)L; { const int q = nwg / NXCD, r = nwg % NXCD, xcd = wgid % NXCD, off = wgid / NXCD; wgid = (xcd < r ? xcd * (q + 1) : r * (q + 1) + (xcd - r) * q) + off; }
        const int nig = WGM * nN, gid = wgid / nig, fm = gid * WGM, gsz = (nM - fm) < WGM ? (nM - fm) : WGM;
        u.pm = fm + ((wgid % nig) % gsz); u.pn = (wgid % nig) / gsz; return true;
    }
    __device__ __forceinline__ void a_ready(const Unit&) const {}
    __device__ __forceinline__ void done(const Unit&) const {}
};

typedef float f32x2 __attribute__((ext_vector_type(2)));
typedef __bf16 bf16x2_t __attribute__((ext_vector_type(2)));
__device__ __forceinline__ unsigned cvt_pk_bf16(float lo, float hi) { f32x2 v = {lo, hi}; bf16x2_t b = __builtin_convertvector(v, bf16x2_t); return __builtin_bit_cast(unsigned, b); }
typedef unsigned u32x2 __attribute__((ext_vector_type(2)));
__device__ __forceinline__ float silu_f(float g) { return g * __builtin_amdgcn_rcpf(1.0f + __expf(-g)); }
struct EpiZ {
    static constexpr bool PERM = true, AFTER_DRAIN = false;
    bf16_t* Z; float* out;
    __device__ __forceinline__ void operator()(const f32x4 (&acc)[2][2][4][2], const Unit& u, int wr, int wc, int fr, int fq) const {
        const int row0 = u.pm * BM + wr * 64 + fr, col0 = u.pn * BM + wc * 32 + 8 * fq;
        const bool kvt = (u.pn == 10), act = (u.pn < 2 || u.pn == 6 || u.pn == 7);
#pragma unroll
        for (int ai = 0; ai < 2; ++ai)
#pragma unroll
            for (int m = 0; m < 4; ++m) {
                const int row = row0 + ai * HALF + m * 16;
                bf16_t* rowp = Z + (size_t)row * INC + col0;
                long kvoff = -1, vdelta = 0;
                if (kvt) {
                    if (row < MP) { const int t = row & (SEQ - 1); if (t >= SEQ - 128) { kvoff = (long)OFF_KP + ((long)(row >> 11) * 128 + (t - (SEQ - 128))) * 128; vdelta = (long)(OFF_VP - OFF_KP); } }
                    else if (row < MP + MS) { kvoff = (long)OFF_KS + (long)(row - MP) * 128; vdelta = (long)(OFF_VS - OFF_KS); }
                }
#pragma unroll
                for (int bj = 0; bj < 2; ++bj) {
                    f32x4 v0 = acc[ai][bj][m][0], v1 = acc[ai][bj][m][1];
                    if (act) {
#pragma unroll
                        for (int e = 0; e < 4; ++e) { v0[e] = silu_f(v0[e]); v1[e] = silu_f(v1[e]); } }
                    u32x4 w; w.x = cvt_pk_bf16(v0[0], v0[1]); w.y = cvt_pk_bf16(v0[2], v0[3]); w.z = cvt_pk_bf16(v1[0], v1[1]); w.w = cvt_pk_bf16(v1[2], v1[3]);
                    __builtin_nontemporal_store(w, (u32x4*)(rowp + bj * HALF));
                    if (kvoff >= 0) { float* d = out + kvoff + (bj ? vdelta : 0) + wc * 32 + 8 * fq; *(f32x4*)d = v0; *(f32x4*)(d + 4) = v1; }
                }
            }
    }
};
struct EpiKV {
    static constexpr bool PERM = true, AFTER_DRAIN = false;
    bf16_t* MKB; bf16_t* MVB; float* out;
    __device__ __forceinline__ void operator()(const f32x4 (&acc)[2][2][4][2], const Unit& u, int wr, int wc, int fr, int fq) const {
        const int row0 = u.pm * BM + wr * 64 + fr; const bool isv = (u.pn >= 4);
        const int col0 = (u.pn & 3) * BM + wc * 32 + 8 * fq;
        bf16_t* B = isv ? MVB : MKB; float* O = out + (isv ? OFF_MV : OFF_MK);
#pragma unroll
        for (int ai = 0; ai < 2; ++ai)
#pragma unroll
            for (int m = 0; m < 4; ++m) {
                const size_t off = (size_t)(row0 + ai * HALF + m * 16) * DM + col0;
#pragma unroll
                for (int bj = 0; bj < 2; ++bj) {
                    const f32x4 v0 = acc[ai][bj][m][0], v1 = acc[ai][bj][m][1];
                    u32x4 w; w.x = cvt_pk_bf16(v0[0], v0[1]); w.y = cvt_pk_bf16(v0[2], v0[3]); w.z = cvt_pk_bf16(v1[0], v1[1]); w.w = cvt_pk_bf16(v1[2], v1[3]);
                    *(u32x4*)(B + off + bj * HALF) = w;
                    *(f32x4*)(O + off + bj * HALF) = v0; *(f32x4*)(O + off + bj * HALF + 4) = v1;
                }
            }
    }
};
struct EpiRes {
    static constexpr bool PERM = true, AFTER_DRAIN = false;
    bf16_t* XPRE; const bf16_t* XB; const float* xp; const float* xs; int mode;
    __device__ __forceinline__ void operator()(const f32x4 (&acc)[2][2][4][2], const Unit& u, int wr, int wc, int fr, int fq) const {
        const int row0 = u.pm * BM + wr * 64 + fr, col0 = u.pn * BM + wc * 32 + 8 * fq;
#pragma unroll
        for (int ai = 0; ai < 2; ++ai)
#pragma unroll
            for (int m = 0; m < 4; ++m) {
                const int row = row0 + ai * HALF + m * 16;
                const float* rf = nullptr;
                if (mode == 0) { if (row < MP) rf = xp + (size_t)row * DM + col0; else if (row < MP + MS) rf = xs + (size_t)(row - MP) * DM + col0; }
#pragma unroll
                for (int bj = 0; bj < 2; ++bj) {
                    f32x4 r0 = (f32x4){0.f, 0.f, 0.f, 0.f}, r1 = r0;
                    if (mode == 0) { if (rf) { r0 = *(const f32x4*)(rf + bj * HALF); r1 = *(const f32x4*)(rf + bj * HALF + 4); } }
                    else { const u32x4 w = *(const u32x4*)(XB + (size_t)row * DM + col0 + bj * HALF);
                        r0 = (f32x4){__uint_as_float(w.x << 16), __uint_as_float(w.x & 0xffff0000u), __uint_as_float(w.y << 16), __uint_as_float(w.y & 0xffff0000u)};
                        r1 = (f32x4){__uint_as_float(w.z << 16), __uint_as_float(w.z & 0xffff0000u), __uint_as_float(w.w << 16), __uint_as_float(w.w & 0xffff0000u)}; }
                    const f32x4 v0 = r0 * ALPHA + acc[ai][bj][m][0], v1 = r1 * ALPHA + acc[ai][bj][m][1];
                    u32x4 o; o.x = cvt_pk_bf16(v0[0], v0[1]); o.y = cvt_pk_bf16(v0[2], v0[3]); o.z = cvt_pk_bf16(v1[0], v1[1]); o.w = cvt_pk_bf16(v1[2], v1[3]);
                    *(u32x4*)(XPRE + (size_t)row * DM + col0 + bj * HALF) = o;
                }
            }
    }
};
struct EpiQ {
    static constexpr bool PERM = true, AFTER_DRAIN = false;
    bf16_t* O; float scale;
    __device__ __forceinline__ void operator()(const f32x4 (&acc)[2][2][4][2], const Unit& u, int wr, int wc, int fr, int fq) const {
        const int row0 = u.pm * BM + wr * 64 + fr, col0 = u.pn * BM + wc * 32 + 8 * fq;
#pragma unroll
        for (int ai = 0; ai < 2; ++ai)
#pragma unroll
            for (int m = 0; m < 4; ++m) {
                bf16_t* rowp = O + (size_t)(row0 + ai * HALF + m * 16) * DM + col0;
#pragma unroll
                for (int bj = 0; bj < 2; ++bj) {
                    const f32x4 v0 = acc[ai][bj][m][0] * scale, v1 = acc[ai][bj][m][1] * scale;
                    u32x4 w; w.x = cvt_pk_bf16(v0[0], v0[1]); w.y = cvt_pk_bf16(v0[2], v0[3]); w.z = cvt_pk_bf16(v1[0], v1[1]); w.w = cvt_pk_bf16(v1[2], v1[3]);
                    *(u32x4*)(rowp + bj * HALF) = w;
                }
            }
    }
};
struct EpiSwiglu {
    static constexpr bool PERM = true, AFTER_DRAIN = false;
    bf16_t* H;
    __device__ __forceinline__ void operator()(const f32x4 (&acc)[2][2][4][2], const Unit& u, int wr, int wc, int fr, int fq) const {
        const int row0 = u.pm * BM + wr * 64 + fr, col0 = u.pn * HALF + wc * 32 + 8 * fq;
#pragma unroll
        for (int ai = 0; ai < 2; ++ai)
#pragma unroll
            for (int m = 0; m < 4; ++m) {
                const f32x4 g0 = acc[ai][0][m][0], g1 = acc[ai][0][m][1], u0 = acc[ai][1][m][0], u1 = acc[ai][1][m][1];
                u32x4 w;
                w.x = cvt_pk_bf16(silu_f(g0[0]) * u0[0], silu_f(g0[1]) * u0[1]); w.y = cvt_pk_bf16(silu_f(g0[2]) * u0[2], silu_f(g0[3]) * u0[3]);
                w.z = cvt_pk_bf16(silu_f(g1[0]) * u1[0], silu_f(g1[1]) * u1[1]); w.w = cvt_pk_bf16(silu_f(g1[2]) * u1[2], silu_f(g1[3]) * u1[3]);
                __builtin_nontemporal_store(w, (u32x4*)(H + (size_t)(row0 + ai * HALF + m * 16) * DFF + col0));
            }
    }
};
struct EpiResLN {
    static constexpr bool PERM = true, AFTER_DRAIN = false;
    const bf16_t* XBres; const float* xp; bf16_t* XBout; float* yout; const float* g; const float* b;
    unsigned long long* xbuf; PG8_LAS unsigned char* xl;
    __device__ __forceinline__ void operator()(f32x4 (&acc)[2][2][4][2], const Unit& u, int wr, int wc, int fr, int fq) const {
        const int wid = wr * 4 + wc, lane = fq * 16 + fr, tid = wid * 64 + lane;
        PG8_LAS f32x2* P = (PG8_LAS f32x2*)xl; PG8_LAS f32x2* S = (PG8_LAS f32x2*)(xl + 8192);
        const int row0 = u.pm * BM + wr * 64 + fr, col0 = u.pn * BM + wc * 32 + 8 * fq;
#pragma unroll
        for (int ai = 0; ai < 2; ++ai)
#pragma unroll
            for (int m = 0; m < 4; ++m) {
                const size_t off = (size_t)(row0 + ai * HALF + m * 16) * DM + col0; float s = 0.f, ss = 0.f;
#pragma unroll
                for (int bj = 0; bj < 2; ++bj) {
                    f32x4 r0, r1;
                    if (xp) { r0 = *(const f32x4*)(xp + off + bj * HALF); r1 = *(const f32x4*)(xp + off + bj * HALF + 4); }
                    else { const u32x4 w = *(const u32x4*)(XBres + off + bj * HALF);
                        r0 = (f32x4){__uint_as_float(w.x << 16), __uint_as_float(w.x & 0xffff0000u), __uint_as_float(w.y << 16), __uint_as_float(w.y & 0xffff0000u)};
                        r1 = (f32x4){__uint_as_float(w.z << 16), __uint_as_float(w.z & 0xffff0000u), __uint_as_float(w.w << 16), __uint_as_float(w.w & 0xffff0000u)}; }
                    const f32x4 v0 = r0 * ALPHA + acc[ai][bj][m][0], v1 = r1 * ALPHA + acc[ai][bj][m][1];
                    acc[ai][bj][m][0] = v0; acc[ai][bj][m][1] = v1;
                    s += ((v0[0] + v0[1]) + (v0[2] + v0[3])) + ((v1[0] + v1[1]) + (v1[2] + v1[3]));
                    ss += ((v0[0] * v0[0] + v0[1] * v0[1]) + (v0[2] * v0[2] + v0[3] * v0[3])) + ((v1[0] * v1[0] + v1[1] * v1[1]) + (v1[2] * v1[2] + v1[3] * v1[3]));
                }
                s += __shfl_xor(s, 16); s += __shfl_xor(s, 32); ss += __shfl_xor(ss, 16); ss += __shfl_xor(ss, 32);
                if (fq == 0) P[(ai * HALF + wr * 64 + m * 16 + fr) * 4 + wc] = (f32x2){s, ss};
            }
        asm volatile("s_waitcnt lgkmcnt(0)" ::: "memory"); __builtin_amdgcn_s_barrier(); asm volatile("" ::: "memory");
        if (tid < 256) {
            const f32x2 a = P[tid * 4 + 0], bb = P[tid * 4 + 1], c = P[tid * 4 + 2], d = P[tid * 4 + 3];
            const float ts0 = (a.x + bb.x) + (c.x + d.x), tss0 = (a.y + bb.y) + (c.y + d.y);
            unsigned long long* slot = xbuf + (size_t)(u.pm * BM + tid) * 4;
            __hip_atomic_store(slot + u.pn, ((unsigned long long)__float_as_uint(tss0) << 32) | __float_as_uint(ts0), __ATOMIC_RELAXED, __HIP_MEMORY_SCOPE_AGENT);
            unsigned long long w[4]; bool ok = false;
            for (unsigned sp = 0; sp < (1u << 18); ++sp) {
#pragma unroll
                for (int t = 0; t < 4; ++t) w[t] = __hip_atomic_load(slot + t, __ATOMIC_RELAXED, __HIP_MEMORY_SCOPE_AGENT);
                ok = (w[0] != ~0ull) && (w[1] != ~0ull) && (w[2] != ~0ull) && (w[3] != ~0ull);
                if (!__any(!ok)) break;
                __builtin_amdgcn_s_sleep(1);
            }
            float ts = 0.f, tss = 0.f;
#pragma unroll
            for (int t = 0; t < 4; ++t) { ts += __uint_as_float((unsigned)w[t]); tss += __uint_as_float((unsigned)(w[t] >> 32)); }
            const float mean = ts * (1.0f / DM), var = fmaxf(tss * (1.0f / DM) - mean * mean, 0.f);
            S[tid] = (f32x2){mean, 1.0f / sqrtf(var + LN_EPS)};
        }
        asm volatile("s_waitcnt vmcnt(0) lgkmcnt(0)" ::: "memory"); __builtin_amdgcn_s_barrier(); asm volatile("" ::: "memory");
        f32x4 gv[2][2], bv[2][2];
#pragma unroll
        for (int bj = 0; bj < 2; ++bj)
#pragma unroll
            for (int n = 0; n < 2; ++n) { gv[bj][n] = *(const f32x4*)(g + col0 + bj * HALF + 4 * n); bv[bj][n] = *(const f32x4*)(b + col0 + bj * HALF + 4 * n); }
#pragma unroll
        for (int ai = 0; ai < 2; ++ai)
#pragma unroll
            for (int m = 0; m < 4; ++m) {
                const int r = ai * HALF + wr * 64 + m * 16 + fr; const f32x2 sr = S[r];
                const size_t off = (size_t)(u.pm * BM + r) * DM + col0;
#pragma unroll
                for (int bj = 0; bj < 2; ++bj) {
                    const f32x4 y0 = (acc[ai][bj][m][0] - sr.x) * sr.y * gv[bj][0] + bv[bj][0], y1 = (acc[ai][bj][m][1] - sr.x) * sr.y * gv[bj][1] + bv[bj][1];
                    if (yout) { *(f32x4*)(yout + off + bj * HALF) = y0; *(f32x4*)(yout + off + bj * HALF + 4) = y1; }
                    else { u32x4 o; o.x = cvt_pk_bf16(y0[0], y0[1]); o.y = cvt_pk_bf16(y0[2], y0[3]); o.z = cvt_pk_bf16(y1[0], y1[1]); o.w = cvt_pk_bf16(y1[2], y1[3]);
                        *(u32x4*)(XBout + off + bj * HALF) = o; }
                }
            }
        asm volatile("s_waitcnt lgkmcnt(0)" ::: "memory"); __builtin_amdgcn_s_barrier(); asm volatile("" ::: "memory");
    }
};
struct EpiSoftmax {
    static constexpr bool PERM = true, AFTER_DRAIN = false;
    bf16_t* Pout; PG8_LAS unsigned char* xl;
    __device__ __forceinline__ void operator()(f32x4 (&acc)[2][2][4][2], const Unit& u, int wr, int wc, int fr, int fq) const {
        PG8_LAS float* Pm = (PG8_LAS float*)xl; PG8_LAS float* Ps = (PG8_LAS float*)(xl + 4096);
        const int row0 = u.pm * BM + wr * 64 + fr, col0 = u.pn * BM + wc * 32 + 8 * fq;
#pragma unroll
        for (int ai = 0; ai < 2; ++ai)
#pragma unroll
            for (int m = 0; m < 4; ++m) { float mx = -1e30f;
#pragma unroll
                for (int bj = 0; bj < 2; ++bj)
#pragma unroll
                    for (int n = 0; n < 2; ++n) { const f32x4 v = acc[ai][bj][m][n]; mx = fmaxf(mx, fmaxf(fmaxf(v[0], v[1]), fmaxf(v[2], v[3]))); }
                mx = fmaxf(mx, __shfl_xor(mx, 16)); mx = fmaxf(mx, __shfl_xor(mx, 32));
                if (fq == 0) Pm[(ai * HALF + wr * 64 + m * 16 + fr) * 4 + wc] = mx; }
        asm volatile("s_waitcnt lgkmcnt(0)" ::: "memory"); __builtin_amdgcn_s_barrier(); asm volatile("" ::: "memory");
#pragma unroll
        for (int ai = 0; ai < 2; ++ai)
#pragma unroll
            for (int m = 0; m < 4; ++m) { const int r = ai * HALF + wr * 64 + m * 16 + fr; const f32x4 q = *(const PG8_LAS f32x4*)(Pm + r * 4);
                const float mx = fmaxf(fmaxf(q[0], q[1]), fmaxf(q[2], q[3])); float sm = 0.f;
#pragma unroll
                for (int bj = 0; bj < 2; ++bj)
#pragma unroll
                    for (int n = 0; n < 2; ++n) { f32x4 v = acc[ai][bj][m][n];
#pragma unroll
                        for (int e = 0; e < 4; ++e) { v[e] = __expf(v[e] - mx); sm += v[e]; }
                        acc[ai][bj][m][n] = v; }
                sm += __shfl_xor(sm, 16); sm += __shfl_xor(sm, 32);
                if (fq == 0) Ps[r * 4 + wc] = sm; }
        asm volatile("s_waitcnt lgkmcnt(0)" ::: "memory"); __builtin_amdgcn_s_barrier(); asm volatile("" ::: "memory");
#pragma unroll
        for (int ai = 0; ai < 2; ++ai)
#pragma unroll
            for (int m = 0; m < 4; ++m) { const int r = ai * HALF + wr * 64 + m * 16 + fr; const f32x4 q = *(const PG8_LAS f32x4*)(Ps + r * 4);
                const float inv = 1.0f / ((q[0] + q[1]) + (q[2] + q[3]));
                bf16_t* rowp = Pout + (size_t)(u.pm * BM + r) * DM + col0;
#pragma unroll
                for (int bj = 0; bj < 2; ++bj) { const f32x4 v0 = acc[ai][bj][m][0] * inv, v1 = acc[ai][bj][m][1] * inv;
                    u32x4 w; w.x = cvt_pk_bf16(v0[0], v0[1]); w.y = cvt_pk_bf16(v0[2], v0[3]); w.z = cvt_pk_bf16(v1[0], v1[1]); w.w = cvt_pk_bf16(v1[2], v1[3]);
                    *(u32x4*)(rowp + bj * HALF) = w; } }
        asm volatile("s_waitcnt lgkmcnt(0)" ::: "memory"); __builtin_amdgcn_s_barrier(); asm volatile("" ::: "memory");
    }
};
template <class Epi, class Sched, bool ALIGN_EPI = false, bool SP2 = false>
__device__ __forceinline__ void gemm_phase(PG8_LAS unsigned char* lds, const Gemm g, const Sched& S, const Epi& E) {
    int tid_ = threadIdx.x; asm volatile("" : "+v"(tid_)); const int tid = tid_, wid = __builtin_amdgcn_readfirstlane(tid >> 6), lane = tid & 63, wr = wid >> 2, wc = wid & 3, fr = lane & 15, fq = lane >> 4;
    const int K = g.K, nt = K / BK;
    unsigned voffA[2], voffB[2];
#pragma unroll
    for (int i = 0; i < 2; ++i) { int R, C; stage_rc(tid * 16 + i * 8192, R, C); const int Rb = Epi::PERM ? ((R & ~31) + perm32(R & 31)) : R;
        voffA[i] = (unsigned)(R * g.lda + C) * 2u; voffB[i] = (unsigned)(Rb * g.ldb + C) * 2u; }
    const size_t kstep = (size_t)(BK * 2);
    const size_t hstepA = (size_t)HALF * g.lda * 2, hstepB = (size_t)HALF * g.ldb * 2;
    const unsigned ldsw = (unsigned)wid * 1024u;
    const int aoff = lds_byte(wr * 64 + fr, fq * 8), boff = lds_byte(wc * 32 + fr, fq * 8);
#define PG8_SA(b, h) (((b) * 2 + (h)) * HTB)
#define PG8_SB(b, h) ((4 + (b) * 2 + (h)) * HTB)
#define PG8_STAGE(bufoff, gbase, voff) do { _Pragma("unroll") for (int _i = 0; _i < 2; ++_i) \
        __builtin_amdgcn_global_load_lds((const unsigned*)((const char*)(gbase) + (voff)[_i]), (PG8_LAS unsigned*)(lds + (bufoff) + ldsw + _i * 8192), 16, 0, 0); } while (0)
#define PG8_LDA(dst, b, h) do { _Pragma("unroll") for (int m = 0; m < 4; ++m) _Pragma("unroll") for (int k = 0; k < 2; ++k) dst[m][k] = *(const PG8_LAS bf16x8*)(lds + PG8_SA(b, h) + aoff + m * 2048 + k * 1024); } while (0)
#define PG8_LDB(dst, b, h) do { _Pragma("unroll") for (int n = 0; n < 2; ++n) _Pragma("unroll") for (int k = 0; k < 2; ++k) dst[n][k] = *(const PG8_LAS bf16x8*)(lds + PG8_SB(b, h) + boff + n * 2048 + k * 1024); } while (0)
#define PG8_MMA(ai, bj, At, Bt) do { __builtin_amdgcn_s_setprio(1); _Pragma("unroll") for (int m = 0; m < 4; ++m) _Pragma("unroll") for (int n = 0; n < 2; ++n) _Pragma("unroll") for (int k = 0; k < 2; ++k) \
        acc[ai][bj][m][n] = __builtin_amdgcn_mfma_f32_16x16x32_bf16(Bt[n][k], At[m][k], acc[ai][bj][m][n], 0, 0, 0); __builtin_amdgcn_s_setprio(0); } while (0)
#define PG8_WAIT_V(n) asm volatile("s_waitcnt vmcnt(" #n ")" ::: "memory")
#define PG8_WAIT_L(n) asm volatile("s_waitcnt lgkmcnt(" #n ")" ::: "memory")
#define PG8_BAR __builtin_amdgcn_s_barrier()
#define PG8_SCHED __builtin_amdgcn_sched_barrier(0)
    Unit cur, nxt; int ui = 0;
    if (!S.next(0, cur)) return;
    f32x4 acc[2][2][4][2];
#pragma unroll
    for (int a = 0; a < 2; ++a)
#pragma unroll
        for (int b = 0; b < 2; ++b)
#pragma unroll
            for (int m = 0; m < 4; ++m)
#pragma unroll
                for (int n = 0; n < 2; ++n) acc[a][b][m][n] = (f32x4){0.f, 0.f, 0.f, 0.f};
    bf16x8 At[4][2], B0[2][2], B1[2][2];
    const char* cA = (const char*)g.A + g.aoff(cur); const char* cB = (const char*)g.Bt + g.boff(cur);
    S.a_ready(cur);
    if constexpr (SP2) {
        PG8_STAGE(PG8_SB(0, 0), cB, voffB); PG8_STAGE(PG8_SB(0, 1), cB + hstepB, voffB); PG8_STAGE(PG8_SA(0, 0), cA, voffA); PG8_STAGE(PG8_SA(0, 1), cA + hstepA, voffA);
        if (wr == 1) PG8_BAR;
        PG8_WAIT_V(2); PG8_BAR;
        PG8_STAGE(PG8_SB(1, 0), cB + kstep, voffB); PG8_STAGE(PG8_SA(1, 0), cA + kstep, voffA); PG8_STAGE(PG8_SB(1, 1), cB + hstepB + kstep, voffB);
        PG8_WAIT_V(6); PG8_BAR;
    } else {
        PG8_STAGE(PG8_SB(0, 0), cB, voffB); PG8_STAGE(PG8_SA(0, 0), cA, voffA); PG8_STAGE(PG8_SB(0, 1), cB + hstepB, voffB); PG8_STAGE(PG8_SA(0, 1), cA + hstepA, voffA);
        if (wr == 1) PG8_BAR;
        PG8_WAIT_V(4); PG8_BAR;
        PG8_STAGE(PG8_SB(1, 0), cB + kstep, voffB); PG8_STAGE(PG8_SA(1, 0), cA + kstep, voffA); PG8_STAGE(PG8_SB(1, 1), cB + hstepB + kstep, voffB);
        PG8_WAIT_V(6); PG8_BAR;
    }
    for (;;) {
        const bool has_next = S.next(ui + 1, nxt);
        const char* nA = has_next ? (const char*)g.A + g.aoff(nxt) : cA; const char* nB = has_next ? (const char*)g.Bt + g.boff(nxt) : cB;
        for (int t = 0; t < nt; t += 2) {
            const bool last = (t == nt - 2);
            const char* a1 = cA + (size_t)(t + 1) * kstep;
            const char* a2 = last ? nA : cA + (size_t)(t + 2) * kstep; const char* b2 = last ? nB : cB + (size_t)(t + 2) * kstep;
            const char* a3 = a2 + kstep; const char* b3 = b2 + kstep;
            if (last && has_next) S.a_ready(nxt);
            if constexpr (SP2) {
            PG8_LDB(B0, 0, 0); PG8_LDB(B1, 0, 1); PG8_SCHED; PG8_LDA(At, 0, 0); PG8_STAGE(PG8_SA(1, 1), a1 + hstepA, voffA);
            PG8_WAIT_V(8); PG8_WAIT_L(0); PG8_BAR; PG8_MMA(0, 0, At, B0); PG8_MMA(0, 1, At, B1); PG8_BAR; PG8_SCHED;
            PG8_LDA(At, 0, 1); PG8_STAGE(PG8_SB(0, 0), b2, voffB); PG8_STAGE(PG8_SB(0, 1), b2 + hstepB, voffB); PG8_STAGE(PG8_SA(0, 0), a2, voffA);
            PG8_WAIT_V(8); PG8_WAIT_L(0); PG8_BAR; PG8_MMA(1, 0, At, B0); PG8_MMA(1, 1, At, B1); PG8_BAR; PG8_SCHED;
            PG8_LDB(B0, 1, 0); PG8_LDB(B1, 1, 1); PG8_SCHED; PG8_LDA(At, 1, 0); PG8_STAGE(PG8_SA(0, 1), a2 + hstepA, voffA);
            PG8_WAIT_V(8); PG8_WAIT_L(0); PG8_BAR; PG8_MMA(0, 0, At, B0); PG8_MMA(0, 1, At, B1); PG8_BAR; PG8_SCHED;
            PG8_LDA(At, 1, 1); PG8_STAGE(PG8_SB(1, 0), b3, voffB); PG8_STAGE(PG8_SB(1, 1), b3 + hstepB, voffB); PG8_STAGE(PG8_SA(1, 0), a3, voffA);
            PG8_WAIT_V(8); PG8_WAIT_L(0); PG8_BAR; PG8_MMA(1, 0, At, B0); PG8_MMA(1, 1, At, B1); PG8_BAR; PG8_SCHED;
            } else {
            PG8_LDB(B0, 0, 0); PG8_SCHED; PG8_LDA(At, 0, 0); PG8_STAGE(PG8_SA(1, 1), a1 + hstepA, voffA);
            PG8_WAIT_L(8); PG8_BAR; PG8_WAIT_L(0); PG8_MMA(0, 0, At, B0); PG8_BAR; PG8_SCHED;
            PG8_LDB(B1, 0, 1); PG8_STAGE(PG8_SB(0, 0), b2, voffB);
            PG8_BAR; PG8_WAIT_L(0); PG8_MMA(0, 1, At, B1); PG8_BAR;
            PG8_LDA(At, 0, 1); PG8_STAGE(PG8_SA(0, 0), a2, voffA);
            PG8_BAR; PG8_WAIT_L(0); PG8_MMA(1, 0, At, B0); PG8_BAR; PG8_SCHED;
            PG8_STAGE(PG8_SB(0, 1), b2 + hstepB, voffB);
            PG8_WAIT_V(6); PG8_BAR; PG8_MMA(1, 1, At, B1); PG8_BAR;
            PG8_LDB(B0, 1, 0); PG8_SCHED; PG8_LDA(At, 1, 0); PG8_STAGE(PG8_SA(0, 1), a2 + hstepA, voffA);
            PG8_WAIT_L(8); PG8_BAR; PG8_WAIT_L(0); PG8_MMA(0, 0, At, B0); PG8_BAR; PG8_SCHED;
            PG8_LDB(B1, 1, 1); PG8_STAGE(PG8_SB(1, 0), b3, voffB);
            PG8_BAR; PG8_WAIT_L(0); PG8_MMA(0, 1, At, B1); PG8_BAR;
            PG8_LDA(At, 1, 1); PG8_STAGE(PG8_SA(1, 0), a3, voffA);
            PG8_BAR; PG8_WAIT_L(0); PG8_MMA(1, 0, At, B0); PG8_BAR; PG8_SCHED;
            PG8_STAGE(PG8_SB(1, 1), b3 + hstepB, voffB);
            PG8_WAIT_V(6); PG8_BAR; PG8_MMA(1, 1, At, B1); PG8_BAR;
            }
        }
        if constexpr (ALIGN_EPI) { if (wr == 0) PG8_BAR; }
        if constexpr (!Epi::AFTER_DRAIN) { E(acc, cur, wr, wc, fr, fq); S.done(cur); }
        if (!has_next) break;
#pragma unroll
        for (int a = 0; a < 2; ++a)
#pragma unroll
            for (int b = 0; b < 2; ++b)
#pragma unroll
                for (int m = 0; m < 4; ++m)
#pragma unroll
                    for (int n = 0; n < 2; ++n) acc[a][b][m][n] = (f32x4){0.f, 0.f, 0.f, 0.f};
        cur = nxt; cA = nA; cB = nB; ++ui;
        if constexpr (ALIGN_EPI) { if (wr == 1) PG8_BAR; }
    }
    PG8_WAIT_V(0);
    if constexpr (!ALIGN_EPI) { if (wr == 0) PG8_BAR; }
    PG8_BAR;
    if constexpr (Epi::AFTER_DRAIN) { E.fused(acc, cur, wr, wc, fr, fq, lds, wid, lane); S.done(cur); }
#undef PG8_SA
#undef PG8_SB
#undef PG8_STAGE
#undef PG8_LDA
#undef PG8_LDB
#undef PG8_MMA
#undef PG8_WAIT_V
#undef PG8_WAIT_L
#undef PG8_BAR
#undef PG8_SCHED
}
}

#define LAS __attribute__((address_space(3)))
typedef unsigned short bf16_t;
using pg8::bf16x8; using pg8::f32x4; using pg8::u32x4; using pg8::u32x2;
typedef float f32x2 __attribute__((ext_vector_type(2)));

struct Params { const float* in[20]; float* out; unsigned char* ws; };

__device__ __forceinline__ int fresh_tid() { int t = threadIdx.x; asm volatile("" : "+v"(t)); return t; }
__device__ __forceinline__ unsigned pkbf(float lo, float hi) { return pg8::cvt_pk_bf16(lo, hi); }
__device__ __forceinline__ float bflo(unsigned u) { return __uint_as_float(u << 16); }
__device__ __forceinline__ float bfhi(unsigned u) { return __uint_as_float(u & 0xffff0000u); }
__device__ __forceinline__ float sigm(float x) { return __builtin_amdgcn_rcpf(1.0f + __expf(-x)); }
__device__ __forceinline__ f32x4 mfma16(bf16x8 x, bf16x8 y, f32x4 c) { return __builtin_amdgcn_mfma_f32_16x16x32_bf16(x, y, c, 0, 0, 0); }
__device__ __forceinline__ bf16x8 ldsfrag(const LAS unsigned char* p) { return *(const LAS bf16x8*)p; }
__device__ __forceinline__ bf16x8 mk8(unsigned a, unsigned b, unsigned c, unsigned d) { u32x4 v = (u32x4){a, b, c, d}; return __builtin_bit_cast(bf16x8, v); }

__device__ __forceinline__ void st8_wt(void* p, u32x2 v) { __hip_atomic_store((unsigned long long*)p, (unsigned long long)v.x | ((unsigned long long)v.y << 32), __ATOMIC_RELAXED, __HIP_MEMORY_SCOPE_AGENT); }
__device__ __forceinline__ void lds_barrier() { asm volatile("s_waitcnt lgkmcnt(0)" ::: "memory"); __builtin_amdgcn_s_barrier(); asm volatile("" ::: "memory"); }
#define SB() __builtin_amdgcn_sched_barrier(0)
__device__ __forceinline__ void transpose_item(const float* W, int K, int N, bf16_t* WT, LAS float* scr, int item, int lane, int mode) {
    const int nblk = N / 32, kb = item / nblk, nb = item % nblk, k0 = 64 * kb, n0 = 32 * nb;
    int d0 = n0;
    if (mode == 1) { const int j = (n0 < DFF) ? n0 : n0 - DFF; d0 = 256 * (j / 128) + (j % 128) + ((n0 < DFF) ? 0 : 128); }
#pragma unroll 8
    for (int i = 0; i < 32; ++i) { const int kk = 2 * i + (lane >> 5); scr[kk * 33 + (lane & 31)] = __builtin_nontemporal_load(W + (size_t)(k0 + kk) * N + n0 + (lane & 31)); }
    asm volatile("s_waitcnt lgkmcnt(0)" ::: "memory");
    const int c = lane & 7;
#pragma unroll
    for (int j = 0; j < 4; ++j) { const int n = (lane >> 3) + 8 * j; const LAS float* s = scr + (8 * c) * 33 + n;
        u32x4 o; o.x = pkbf(s[0 * 33], s[1 * 33]); o.y = pkbf(s[2 * 33], s[3 * 33]); o.z = pkbf(s[4 * 33], s[5 * 33]); o.w = pkbf(s[6 * 33], s[7 * 33]);
        *(u32x4*)(WT + (size_t)(d0 + n) * K + k0 + 8 * c) = o; }
    asm volatile("s_waitcnt lgkmcnt(0)" ::: "memory");
}
__device__ __forceinline__ void cvt_copy(const float* src, bf16_t* dst, size_t n8, size_t gt, size_t nt) {
    size_t i = gt;
    for (; i + nt < n8; i += 2 * nt) {
        const f32x4 a0 = __builtin_nontemporal_load((const f32x4*)(src + i * 8)), b0 = __builtin_nontemporal_load((const f32x4*)(src + i * 8 + 4));
        const f32x4 a1 = __builtin_nontemporal_load((const f32x4*)(src + (i + nt) * 8)), b1 = __builtin_nontemporal_load((const f32x4*)(src + (i + nt) * 8 + 4));
        u32x4 o0, o1; o0.x = pkbf(a0[0], a0[1]); o0.y = pkbf(a0[2], a0[3]); o0.z = pkbf(b0[0], b0[1]); o0.w = pkbf(b0[2], b0[3]);
        o1.x = pkbf(a1[0], a1[1]); o1.y = pkbf(a1[2], a1[3]); o1.z = pkbf(b1[0], b1[1]); o1.w = pkbf(b1[2], b1[3]);
        *(u32x4*)(dst + i * 8) = o0; *(u32x4*)(dst + (i + nt) * 8) = o1; }
    for (; i < n8; i += nt) { const f32x4 a = __builtin_nontemporal_load((const f32x4*)(src + i * 8)), b = __builtin_nontemporal_load((const f32x4*)(src + i * 8 + 4));
        u32x4 o; o.x = pkbf(a[0], a[1]); o.y = pkbf(a[2], a[3]); o.z = pkbf(b[0], b[1]); o.w = pkbf(b[2], b[3]); *(u32x4*)(dst + i * 8) = o; }
}
__device__ __forceinline__ void zero16(void* dst, size_t n16, size_t gt, size_t nt) { for (size_t i = gt; i < n16; i += nt) ((u32x4*)dst)[i] = (u32x4){0u, 0u, 0u, 0u}; }

constexpr int HG_QG = 0, HG_KG = 17408, HG_KDT = 34816, HG_VT = 53248, HG_ST = 71680, HG_AL = 106496, HG_PART = 115712, HG_EGL = 119808, HG_SSQ = 120320;
template <int L, int NCHUNK, bool HAS_S0>
__device__ __forceinline__ void hgrn_item(const bf16_t* __restrict__ Z, bf16_t* __restrict__ MIX, const float* __restrict__ lbl, const float* __restrict__ gnorm,
                                          const float* __restrict__ S0, float* __restrict__ Sout, LAS unsigned char* lds, int rowbase, int h) {
    constexpr int nchunk = NCHUNK;
    const int tid = fresh_tid(), lane = tid & 63, w = __builtin_amdgcn_readfirstlane(tid >> 6), fr = lane & 15, fq = lane >> 4;
    LAS unsigned char* QG = lds + HG_QG; LAS unsigned char* KG = lds + HG_KG; LAS unsigned char* KDT = lds + HG_KDT; LAS unsigned char* VT = lds + HG_VT;
    LAS unsigned char* STL = lds + HG_ST; LAS unsigned char* AL = lds + HG_AL;
    LAS float* PART = (LAS float*)(lds + HG_PART); LAS float* EGL = (LAS float*)(lds + HG_EGL); LAS float* SSQ = (LAS float*)(lds + HG_SSQ);
    const int ch = 2 * lane;
    float lb0, lb1;
    { const float a0 = lbl[h * 128 + ch], a1 = lbl[512 + h * 128 + ch], b0 = lbl[h * 128 + ch + 1], b1 = lbl[512 + h * 128 + ch + 1];
      lb0 = 1.0f / (1.0f + __expf(a1 - a0)); lb1 = 1.0f / (1.0f + __expf(b1 - b0)); }
    f32x4 S[8];
#pragma unroll
    for (int dt = 0; dt < 8; ++dt)
#pragma unroll
        for (int i = 0; i < 4; ++i) S[dt][i] = HAS_S0 ? S0[(16 * w + 4 * fq + i) * 128 + 16 * dt + fr] : 0.f;
    unsigned rq[8], rf[8], ri[8]; u32x2 hgn[4];
    const int tt = w >> 1, dh = w & 1, tok = 16 * tt + fr; const bool tvalid = tok < L;
#define HG_LOAD(c_) do { _Pragma("unroll") for (int i = 0; i < 8; ++i) { const bf16_t* zp = Z + (size_t)(rowbase + (c_) * 64 + 8 * w + i) * INC + h * 128 + ch; \
        if (8 * w + i < L) { rq[i] = *(const unsigned*)(zp + ZC_HQ); rf[i] = *(const unsigned*)(zp + ZC_HF); ri[i] = *(const unsigned*)(zp + ZC_HI); } else { rq[i] = 0u; rf[i] = 0u; ri[i] = 0u; } } \
        _Pragma("unroll") for (int j = 0; j < 4; ++j) hgn[j] = tvalid ? *(const u32x2*)(Z + (size_t)(rowbase + (c_) * 64 + tok) * INC + ZC_HG + h * 128 + 16 * (4 * dh + j) + 4 * fq) : (u32x2){0u, 0u}; } while (0)
    HG_LOAD(0);
    f32x4 oP[4]; u32x2 hgP[4]; size_t rowP = 0;
#define HG_EPILOGUE() do { const f32x2 sq_ = *(const LAS f32x2*)(SSQ + tok * 2); const float rstd_ = rsqrtf((sq_.x + sq_.y) * (1.0f / 128.0f) + 1e-6f); \
        if (tvalid) { _Pragma("unroll") for (int j = 0; j < 4; ++j) { const int dv_ = 16 * (4 * dh + j) + 4 * fq; const f32x4 gn_ = *(const f32x4*)(gnorm + dv_); \
            const float g0_ = bflo(hgP[j].x), g1_ = bfhi(hgP[j].x), g2_ = bflo(hgP[j].y), g3_ = bfhi(hgP[j].y);     \
            *(u32x2*)(MIX + rowP * DM + h * 128 + dv_) = (u32x2){pkbf(oP[j][0] * rstd_ * gn_[0] * g0_, oP[j][1] * rstd_ * gn_[1] * g1_), pkbf(oP[j][2] * rstd_ * gn_[2] * g2_, oP[j][3] * rstd_ * gn_[3] * g3_)}; } } } while (0)
    for (int c = 0; c < nchunk; ++c) {
        float P0[8], P1[8], k0[8], k1[8];
        { float c0 = 1.f, c1 = 1.f;
#pragma unroll
          for (int i = 0; i < 8; ++i) { const bool valid = (8 * w + i < L);
              const float f0 = lb0 + (1.0f - lb0) * sigm(bflo(rf[i])), f1 = lb1 + (1.0f - lb1) * sigm(bfhi(rf[i]));
              c0 *= valid ? f0 : 1.f; c1 *= valid ? f1 : 1.f; P0[i] = c0; P1[i] = c1; k0[i] = valid ? 1.0f - f0 : 0.f; k1[i] = valid ? 1.0f - f1 : 0.f; }
          *(LAS f32x2*)(PART + w * 128 + ch) = (f32x2){c0, c1}; }
        lds_barrier();
        if (c > 0) HG_EPILOGUE();
        float pre0 = 1.f, pre1 = 1.f, GL0 = 1.f, GL1 = 1.f;
#pragma unroll
        for (int ww = 0; ww < 8; ++ww) { const f32x2 p = *(const LAS f32x2*)(PART + ww * 128 + ch); GL0 *= p.x; GL1 *= p.y; if (ww < w) { pre0 *= p.x; pre1 *= p.y; } }
        { unsigned kd0[4], kd1[4];
#pragma unroll
          for (int i = 0; i < 8; ++i) { const float e0 = pre0 * P0[i], e1 = pre1 * P1[i], r0 = __builtin_amdgcn_rcpf(e0), r1 = __builtin_amdgcn_rcpf(e1);
              const float q0 = bflo(rq[i]), q1 = bfhi(rq[i]);
              *(LAS unsigned*)(QG + (8 * w + i) * 272 + ch * 2) = pkbf(q0 * e0, q1 * e1);
              const float kg0 = k0[i] * r0, kg1 = k1[i] * r1;
              *(LAS unsigned*)(KG + (8 * w + i) * 272 + ch * 2) = pkbf(kg0, kg1);
              k0[i] = kg0 * GL0; k1[i] = kg1 * GL1; }
#pragma unroll
          for (int i = 0; i < 4; ++i) { kd0[i] = pkbf(k0[2 * i], k0[2 * i + 1]); kd1[i] = pkbf(k1[2 * i], k1[2 * i + 1]); }
          *(LAS u32x4*)(KDT + ch * 144 + 16 * w) = (u32x4){kd0[0], kd0[1], kd0[2], kd0[3]};
          *(LAS u32x4*)(KDT + (ch + 1) * 144 + 16 * w) = (u32x4){kd1[0], kd1[1], kd1[2], kd1[3]};
          u32x4 va, vb;
          va.x = (ri[0] & 0xffffu) | (ri[1] << 16); va.y = (ri[2] & 0xffffu) | (ri[3] << 16); va.z = (ri[4] & 0xffffu) | (ri[5] << 16); va.w = (ri[6] & 0xffffu) | (ri[7] << 16);
          vb.x = (ri[0] >> 16) | (ri[1] & 0xffff0000u); vb.y = (ri[2] >> 16) | (ri[3] & 0xffff0000u); vb.z = (ri[4] >> 16) | (ri[5] & 0xffff0000u); vb.w = (ri[6] >> 16) | (ri[7] & 0xffff0000u);
          *(LAS u32x4*)(VT + ch * 144 + 16 * w) = va; *(LAS u32x4*)(VT + (ch + 1) * 144 + 16 * w) = vb; }
        if (w == 0) *(LAS f32x2*)(EGL + ch) = (f32x2){GL0, GL1};
#pragma unroll
        for (int dt = 0; dt < 8; ++dt) *(LAS u32x2*)(STL + (16 * dt + fr) * 272 + (16 * w + 4 * fq) * 2) = (u32x2){pkbf(S[dt][0], S[dt][1]), pkbf(S[dt][2], S[dt][3])};
        u32x2 hg[4];
#pragma unroll
        for (int j = 0; j < 4; ++j) hg[j] = hgn[j];
        if (c + 1 < nchunk) HG_LOAD(c + 1);
        lds_barrier();
        { const f32x4 eg = *(const LAS f32x4*)(EGL + 16 * w + 4 * fq);
          const bf16x8 xk0 = ldsfrag(KDT + (16 * w + fr) * 144 + (8 * fq) * 2), xk1 = ldsfrag(KDT + (16 * w + fr) * 144 + (32 + 8 * fq) * 2);
#pragma unroll
          for (int b4 = 0; b4 < 2; ++b4) { bf16x8 v0[4], v1[4];
#pragma unroll
              for (int d = 0; d < 4; ++d) { v0[d] = ldsfrag(VT + (16 * (4 * b4 + d) + fr) * 144 + (8 * fq) * 2); v1[d] = ldsfrag(VT + (16 * (4 * b4 + d) + fr) * 144 + (32 + 8 * fq) * 2); }
#pragma unroll
              for (int d = 0; d < 4; ++d) S[4 * b4 + d] = S[4 * b4 + d] * eg;
              SB();
#pragma unroll
              for (int d = 0; d < 4; ++d) S[4 * b4 + d] = mfma16(xk0, v0[d], S[4 * b4 + d]);
#pragma unroll
              for (int d = 0; d < 4; ++d) S[4 * b4 + d] = mfma16(xk1, v1[d], S[4 * b4 + d]);
              SB(); } }
        { const int st0 = 2 * (w & 1); f32x4 a[2]; a[0] = (f32x4){0.f, 0.f, 0.f, 0.f}; a[1] = a[0];
          if (st0 <= tt) { bf16x8 qf[4], kf[2][4];
#pragma unroll
              for (int kb = 0; kb < 4; ++kb) { qf[kb] = ldsfrag(QG + (16 * tt + fr) * 272 + (32 * kb + 8 * fq) * 2);
                  kf[0][kb] = ldsfrag(KG + (16 * st0 + fr) * 272 + (32 * kb + 8 * fq) * 2); kf[1][kb] = ldsfrag(KG + (16 * (st0 + 1) + fr) * 272 + (32 * kb + 8 * fq) * 2); }
              SB();
#pragma unroll
              for (int kb = 0; kb < 4; ++kb) { a[0] = mfma16(kf[0][kb], qf[kb], a[0]); a[1] = mfma16(kf[1][kb], qf[kb], a[1]); }
              SB(); }
#pragma unroll
          for (int j = 0; j < 2; ++j) { const int st = st0 + j;
              if (st > tt) a[j] = (f32x4){0.f, 0.f, 0.f, 0.f};
              if (st == tt) {
#pragma unroll
                  for (int i = 0; i < 4; ++i) if (4 * fq + i > fr) a[j][i] = 0.f; }
              *(LAS u32x2*)(AL + (16 * tt + fr) * 144 + (16 * st + 4 * fq) * 2) = (u32x2){pkbf(a[j][0], a[j][1]), pkbf(a[j][2], a[j][3])}; } }
        lds_barrier();
        { const size_t row = (size_t)(rowbase + c * 64 + tok);
          bf16x8 ya[2], yq[4];
#pragma unroll
          for (int kb = 0; kb < 2; ++kb) ya[kb] = ldsfrag(AL + (16 * tt + fr) * 144 + (32 * kb + 8 * fq) * 2);
#pragma unroll
          for (int kb = 0; kb < 4; ++kb) yq[kb] = ldsfrag(QG + (16 * tt + fr) * 272 + (32 * kb + 8 * fq) * 2);
          f32x4 o[4]; float ss = 0.f;
#pragma unroll
          for (int jp = 0; jp < 2; ++jp) { bf16x8 vf[2][2], sf[2][4];
#pragma unroll
              for (int t = 0; t < 2; ++t) { const int dt = 4 * dh + 2 * jp + t;
#pragma unroll
                  for (int kb = 0; kb < 2; ++kb) vf[t][kb] = ldsfrag(VT + (16 * dt + fr) * 144 + (32 * kb + 8 * fq) * 2);
#pragma unroll
                  for (int kb = 0; kb < 4; ++kb) sf[t][kb] = ldsfrag(STL + (16 * dt + fr) * 272 + (32 * kb + 8 * fq) * 2); }
              SB();
              o[2 * jp] = (f32x4){0.f, 0.f, 0.f, 0.f}; o[2 * jp + 1] = (f32x4){0.f, 0.f, 0.f, 0.f};
#pragma unroll
              for (int kb = 0; kb < 2; ++kb) { o[2 * jp] = mfma16(vf[0][kb], ya[kb], o[2 * jp]); o[2 * jp + 1] = mfma16(vf[1][kb], ya[kb], o[2 * jp + 1]); }
#pragma unroll
              for (int kb = 0; kb < 4; ++kb) { o[2 * jp] = mfma16(sf[0][kb], yq[kb], o[2 * jp]); o[2 * jp + 1] = mfma16(sf[1][kb], yq[kb], o[2 * jp + 1]); }
              SB(); }
#pragma unroll
          for (int j = 0; j < 4; ++j) ss += (o[j][0] * o[j][0] + o[j][1] * o[j][1]) + (o[j][2] * o[j][2] + o[j][3] * o[j][3]);
          ss += __shfl_xor(ss, 16); ss += __shfl_xor(ss, 32);
          if (fq == 0) SSQ[tok * 2 + dh] = ss;
#pragma unroll
          for (int j = 0; j < 4; ++j) { oP[j] = o[j]; hgP[j] = hg[j]; }
          rowP = row; }
    }
    lds_barrier();
    HG_EPILOGUE();
#undef HG_LOAD
#undef HG_EPILOGUE
#pragma unroll
    for (int dt = 0; dt < 8; ++dt)
#pragma unroll
        for (int i = 0; i < 4; ++i) Sout[(16 * w + 4 * fq + i) * 128 + 16 * dt + fr] = S[dt][i];
    __syncthreads();
}

constexpr int SW_K = 0, SW_VT = 27648;
template <int SAMPLE>
__device__ __forceinline__ void swa_item(const bf16_t* __restrict__ Z, bf16_t* __restrict__ MIX, const float* __restrict__ ck, const float* __restrict__ cv, const float* __restrict__ sinks,
                                         LAS unsigned char* lds, int b, int c, int hk) {
    const int tid = fresh_tid(), lane = tid & 63, w = __builtin_amdgcn_readfirstlane(tid >> 6), fr = lane & 15, fq = lane >> 4;
    LAS unsigned char* KL = lds + SW_K; LAS unsigned char* VTL = lds + SW_VT;
    const int krow0 = SAMPLE ? 0 : b * SEQ + (c - 2) * 64;
    u32x4 kv[3]; unsigned vv[2][8];
    const int dp = tid & 31, gk = tid >> 5;
    if (SAMPLE) {
#pragma unroll
        for (int it = 0; it < 2; ++it) { const int idx = tid + 512 * it, j = idx >> 3, c16 = idx & 7;
            const float* sp = ck + ((size_t)(b * 128 + j) * 2 + hk) * 64 + c16 * 8; const f32x4 a = *(const f32x4*)sp, bb = *(const f32x4*)(sp + 4);
            kv[it] = (u32x4){pkbf(a[0], a[1]), pkbf(a[2], a[3]), pkbf(bb[0], bb[1]), pkbf(bb[2], bb[3])}; }
        { const int idx = tid + 1024, j = idx >> 3, c16 = idx & 7; const bool ok = j < 144;
          const u32x4 t = *(const u32x4*)(Z + (size_t)(MP + b * 16 + (ok ? j - 128 : 0)) * INC + ZC_AK + hk * 64 + c16 * 8); kv[2] = ok ? t : (u32x4){0u, 0u, 0u, 0u}; }
#pragma unroll
        for (int i = 0; i < 8; ++i) { const int j = 8 * gk + i; const f32x2 a = *(const f32x2*)(cv + ((size_t)(b * 128 + j) * 2 + hk) * 64 + 2 * dp); vv[0][i] = pkbf(a.x, a.y); }
#pragma unroll
        for (int i = 0; i < 8; ++i) { const int j = 8 * (gk + 16) + i; const bool ok = j < 144;
            const unsigned t = *(const unsigned*)(Z + (size_t)(MP + b * 16 + (ok ? j - 128 : 0)) * INC + ZC_AV + hk * 64 + 2 * dp); vv[1][i] = ok ? t : 0u; }
    } else {
#pragma unroll
        for (int it = 0; it < 3; ++it) { const int idx = tid + 512 * it, j = idx >> 3, c16 = idx & 7; const bool ok = (c - 2 + (j >> 6) >= 0);
            const u32x4 t = *(const u32x4*)(Z + (size_t)(ok ? krow0 + j : b * SEQ) * INC + ZC_AK + hk * 64 + c16 * 8); kv[it] = ok ? t : (u32x4){0u, 0u, 0u, 0u}; }
#pragma unroll
        for (int r = 0; r < 2; ++r)
#pragma unroll
            for (int i = 0; i < 8; ++i) { const int j = (8 * (gk + 16 * r) + i) % 192; const bool ok = (c - 2 + (j >> 6) >= 0);
                const unsigned t = *(const unsigned*)(Z + (size_t)(ok ? krow0 + j : b * SEQ) * INC + ZC_AV + hk * 64 + 2 * dp); vv[r][i] = ok ? t : 0u; }
    }
    const int g = w >> 1, tq0 = 32 * (w & 1), hh = hk * 4 + g;
    bf16x8 yq[2][2]; size_t qrow[2];
#pragma unroll
    for (int qt = 0; qt < 2; ++qt) { const int tok = tq0 + 16 * qt + fr; qrow[qt] = SAMPLE ? (size_t)(MP + b * 16 + (tok & 15)) : (size_t)(b * SEQ + c * 64 + tok);
#pragma unroll
        for (int dk = 0; dk < 2; ++dk) yq[qt][dk] = *(const bf16x8*)(Z + qrow[qt] * INC + ZC_AQ + hk * 256 + g * 64 + 32 * dk + 8 * fq); }
#pragma unroll
    for (int it = 0; it < 3; ++it) { const int idx = tid + 512 * it; *(LAS u32x4*)(KL + (idx >> 3) * 144 + (idx & 7) * 16) = kv[it]; }
#pragma unroll
    for (int r = 0; r < 2; ++r) { const int kg = gk + 16 * r;
        if (kg < 24) { u32x4 va, vb;
            va.x = (vv[r][0] & 0xffffu) | (vv[r][1] << 16); va.y = (vv[r][2] & 0xffffu) | (vv[r][3] << 16); va.z = (vv[r][4] & 0xffffu) | (vv[r][5] << 16); va.w = (vv[r][6] & 0xffffu) | (vv[r][7] << 16);
            vb.x = (vv[r][0] >> 16) | (vv[r][1] & 0xffff0000u); vb.y = (vv[r][2] >> 16) | (vv[r][3] & 0xffff0000u); vb.z = (vv[r][4] >> 16) | (vv[r][5] & 0xffff0000u); vb.w = (vv[r][6] >> 16) | (vv[r][7] & 0xffff0000u);
            *(LAS u32x4*)(VTL + (2 * dp) * 400 + kg * 16) = va; *(LAS u32x4*)(VTL + (2 * dp + 1) * 400 + kg * 16) = vb; } }
    lds_barrier();
    f32x4 S[2][12];
#pragma unroll
    for (int kq = 0; kq < 3; ++kq) { bf16x8 xk[4][2];
#pragma unroll
        for (int t = 0; t < 4; ++t)
#pragma unroll
            for (int dk = 0; dk < 2; ++dk) xk[t][dk] = ldsfrag(KL + (16 * (4 * kq + t) + fr) * 144 + (32 * dk + 8 * fq) * 2);
        SB();
#pragma unroll
        for (int t = 0; t < 4; ++t) { S[0][4 * kq + t] = (f32x4){0.f, 0.f, 0.f, 0.f}; S[1][4 * kq + t] = (f32x4){0.f, 0.f, 0.f, 0.f}; }
#pragma unroll
        for (int dk = 0; dk < 2; ++dk)
#pragma unroll
            for (int t = 0; t < 4; ++t) { S[0][4 * kq + t] = mfma16(xk[t][dk], yq[0][dk], S[0][4 * kq + t]); S[1][4 * kq + t] = mfma16(xk[t][dk], yq[1][dk], S[1][4 * kq + t]); }
        SB(); }
    const float slope = exp2f(-(float)(hh + 1)), sink = sinks[hh];
    float inv[2];
#pragma unroll
    for (int qt = 0; qt < 2; ++qt) { const int tq = tq0 + 16 * qt + fr; float m = sink;
#pragma unroll
        for (int kt = 0; kt < 12; ++kt)
#pragma unroll
            for (int i = 0; i < 4; ++i) { const int j = 16 * kt + 4 * fq + i; const bool ok = SAMPLE ? (j < 144) : (c - 2 + (kt >> 2) >= 0);
                float s = S[qt][kt][i] * 0.125f - slope * fabsf((float)(128 + tq - j)); s = ok ? s : -1e30f; S[qt][kt][i] = s; m = fmaxf(m, s); }
        m = fmaxf(m, __shfl_xor(m, 16)); m = fmaxf(m, __shfl_xor(m, 32));
        float l = 0.f;
#pragma unroll
        for (int kt = 0; kt < 12; ++kt)
#pragma unroll
            for (int i = 0; i < 4; ++i) { const float p = __expf(S[qt][kt][i] - m); S[qt][kt][i] = p; l += p; }
        l += __shfl_xor(l, 16); l += __shfl_xor(l, 32); l += __expf(sink - m);
        inv[qt] = 1.0f / l; }
    f32x4 O[2][4];
#pragma unroll
    for (int qt = 0; qt < 2; ++qt)
#pragma unroll
        for (int dt = 0; dt < 4; ++dt) O[qt][dt] = (f32x4){0.f, 0.f, 0.f, 0.f};
#pragma unroll
    for (int kk = 0; kk < 6; ++kk) { bf16x8 yp[2];
#pragma unroll
        for (int qt = 0; qt < 2; ++qt) yp[qt] = mk8(pkbf(S[qt][2 * kk][0], S[qt][2 * kk][1]), pkbf(S[qt][2 * kk][2], S[qt][2 * kk][3]), pkbf(S[qt][2 * kk + 1][0], S[qt][2 * kk + 1][1]), pkbf(S[qt][2 * kk + 1][2], S[qt][2 * kk + 1][3]));
        u32x2 vlo[4], vhi[4];
#pragma unroll
        for (int dt = 0; dt < 4; ++dt) { const LAS unsigned char* vp = VTL + (16 * dt + fr) * 400 + (32 * kk + 4 * fq) * 2; vlo[dt] = *(const LAS u32x2*)vp; vhi[dt] = *(const LAS u32x2*)(vp + 32); }
        SB();
#pragma unroll
        for (int dt = 0; dt < 4; ++dt) { const bf16x8 xv = mk8(vlo[dt].x, vlo[dt].y, vhi[dt].x, vhi[dt].y);
            O[0][dt] = mfma16(xv, yp[0], O[0][dt]); O[1][dt] = mfma16(xv, yp[1], O[1][dt]); }
        SB(); }
#pragma unroll
    for (int qt = 0; qt < 2; ++qt) { const bool st = SAMPLE ? ((w & 1) == 0 && qt == 0) : true;
        if (st) {
#pragma unroll
            for (int dt = 0; dt < 4; ++dt) *(u32x2*)(MIX + qrow[qt] * DM + 512 + hk * 256 + g * 64 + 16 * dt + 4 * fq) = (u32x2){pkbf(O[qt][dt][0] * inv[qt], O[qt][dt][1] * inv[qt]), pkbf(O[qt][dt][2] * inv[qt], O[qt][dt][3] * inv[qt])}; } }
    lds_barrier();
}

typedef float f32x16 __attribute__((ext_vector_type(16)));
__device__ __forceinline__ f32x16 mfma32(bf16x8 x, bf16x8 y, f32x16 c) { return __builtin_amdgcn_mfma_f32_32x32x16_bf16(x, y, c, 0, 0, 0); }
constexpr int MA_K = 0, MA_KS = 272, MA_VT = 34816, MA_VS = 264;
constexpr int MA_NU_P = (MP / 256) * 4, MA_NU = MA_NU_P + SBATCH * 4;
__device__ __forceinline__ void memattn_phase(const bf16_t* __restrict__ Q, const bf16_t* __restrict__ MKB, const bf16_t* __restrict__ MVB, bf16_t* __restrict__ OB, LAS unsigned char* lds, int bx, int G) {
    const int tid = fresh_tid(), lane = tid & 63, w = __builtin_amdgcn_readfirstlane(tid >> 6), l31 = lane & 31, hi = lane >> 5;
    LAS unsigned char* KB = lds + MA_K; LAS unsigned char* VTB = lds + MA_VT;
    const int kkey = tid >> 4, kc16 = tid & 15;
    const int vdp = tid & 63, vg = tid >> 6;
    u32x4 kreg[4]; unsigned vreg[16];
#define MA_UNIT(u_, qrow_, memrow0_, h_, smp_) do { if ((u_) < MA_NU_P) { const int bh_ = (u_) >> 3, rt_ = (u_) & 7; qrow_ = (bh_ >> 2) * SEQ + rt_ * 256 + 32 * w + l31; memrow0_ = (bh_ >> 2) * MEMT; h_ = bh_ & 3; smp_ = false; } \
        else { const int bs_ = ((u_) - MA_NU_P) >> 2; qrow_ = MP + bs_ * SSEQ + (l31 & 15); memrow0_ = MEMROWS_P + bs_ * MEMT; h_ = ((u_) - MA_NU_P) & 3; smp_ = true; } } while (0)
#define MA_LOADK(memrow0_, h_, st_) do { const unsigned o_ = (unsigned)((memrow0_) + 128 * ((st_) & 1) + kkey) * DM + (h_) * 256 + 128 * ((st_) >> 1) + kc16 * 8; \
        _Pragma("unroll") for (int it = 0; it < 4; ++it) kreg[it] = *(const u32x4*)(MKB + (o_ + (unsigned)(32 * it * DM))); } while (0)
#define MA_LOADV(memrow0_, h_, st_) do { const unsigned o_ = (unsigned)((memrow0_) + 128 * ((st_) & 1) + 8 * vg) * DM + (h_) * 256 + 128 * ((st_) >> 1) + 2 * vdp; \
        _Pragma("unroll") for (int r = 0; r < 2; ++r) _Pragma("unroll") for (int i = 0; i < 8; ++i) vreg[8 * r + i] = *(const unsigned*)(MVB + (o_ + (unsigned)((64 * r + i) * DM))); } while (0)
    int u = (G % 8 == 0) ? (bx & 7) * (G >> 3) + (bx >> 3) : bx;
    if (u >= MA_NU) return;
    int qrow, memrow0, h; bool smp;
    MA_UNIT(u, qrow, memrow0, h, smp);
    MA_LOADK(memrow0, h, 0);
    for (;;) {
        f32x16 S[8];
        bf16x8 yq[8];
#pragma unroll
        for (int st = 0; st < 4; ++st) { const int dh = st >> 1, kb2 = st & 1;
            if (kb2 == 0) {
#pragma unroll
                for (int dk = 0; dk < 8; ++dk) yq[dk] = *(const bf16x8*)(Q + ((unsigned)qrow * DM + (unsigned)(h * 256 + 128 * dh + 16 * dk + 8 * hi))); }
#pragma unroll
            for (int it = 0; it < 4; ++it) *(LAS u32x4*)(KB + (32 * it + kkey) * MA_KS + kc16 * 16) = kreg[it];
            if (st < 3) MA_LOADK(memrow0, h, st + 1); else MA_LOADV(memrow0, h, 0);
            lds_barrier();
            if (dh == 0) {
#pragma unroll
                for (int t4 = 0; t4 < 4; ++t4)
#pragma unroll
                    for (int r = 0; r < 16; ++r) S[4 * kb2 + t4][r] = 0.f; }
#pragma unroll
            for (int tp = 0; tp < 2; ++tp)
#pragma unroll
                for (int dg = 0; dg < 4; ++dg) { bf16x8 kf[2][2];
#pragma unroll
                    for (int t = 0; t < 2; ++t)
#pragma unroll
                        for (int d2 = 0; d2 < 2; ++d2) kf[t][d2] = ldsfrag(KB + (32 * (2 * tp + t) + l31) * MA_KS + (16 * (2 * dg + d2) + 8 * hi) * 2);
                    SB();
#pragma unroll
                    for (int d2 = 0; d2 < 2; ++d2)
#pragma unroll
                        for (int t = 0; t < 2; ++t) S[4 * kb2 + 2 * tp + t] = mfma32(kf[t][d2], yq[2 * dg + d2], S[4 * kb2 + 2 * tp + t]);
                    SB(); }
            lds_barrier();
        }
        float m = -1e30f;
#pragma unroll
        for (int t = 0; t < 8; ++t)
#pragma unroll
            for (int r = 0; r < 16; ++r) m = fmaxf(m, S[t][r]);
        m = fmaxf(m, __shfl_xor(m, 32));
        float l = 0.f; unsigned Pk[8][8];
#pragma unroll
        for (int t = 0; t < 8; ++t)
#pragma unroll
            for (int r = 0; r < 16; r += 2) { const float p0 = __expf(S[t][r] - m), p1 = __expf(S[t][r + 1] - m); l += p0 + p1; Pk[t][r >> 1] = pkbf(p0, p1); }
        l += __shfl_xor(l, 32);
        const float inv = 1.0f / l;
        const int un = u + G; const bool has_next = un < MA_NU;
        int nqrow = 0, nm0 = 0, nh = 0; bool nsmp = false;
        if (has_next) MA_UNIT(un, nqrow, nm0, nh, nsmp);
        f32x16 O[4];
#pragma unroll
        for (int st = 0; st < 4; ++st) { const int dh = st >> 1, kb2 = st & 1;
            if (kb2 == 0) {
#pragma unroll
                for (int dt = 0; dt < 4; ++dt)
#pragma unroll
                    for (int r = 0; r < 16; ++r) O[dt][r] = 0.f; }
#pragma unroll
            for (int r = 0; r < 2; ++r) { unsigned vv[8]; _Pragma("unroll") for (int i = 0; i < 8; ++i) vv[i] = vreg[8 * r + i]; const int kg = vg + 8 * r;
                LAS unsigned char* pa = VTB + (2 * vdp) * MA_VS + kg * 16; LAS unsigned char* pb = pa + MA_VS;
                *(LAS u32x2*)pa = (u32x2){(vv[0] & 0xffffu) | (vv[1] << 16), (vv[2] & 0xffffu) | (vv[3] << 16)}; *(LAS u32x2*)(pa + 8) = (u32x2){(vv[4] & 0xffffu) | (vv[5] << 16), (vv[6] & 0xffffu) | (vv[7] << 16)};
                *(LAS u32x2*)pb = (u32x2){(vv[0] >> 16) | (vv[1] & 0xffff0000u), (vv[2] >> 16) | (vv[3] & 0xffff0000u)}; *(LAS u32x2*)(pb + 8) = (u32x2){(vv[4] >> 16) | (vv[5] & 0xffff0000u), (vv[6] >> 16) | (vv[7] & 0xffff0000u)}; }
            if (st < 3) MA_LOADV(memrow0, h, st + 1); else if (has_next) MA_LOADK(nm0, nh, 0);
            lds_barrier();
#pragma unroll
            for (int t4 = 0; t4 < 4; ++t4) { const int T = 4 * kb2 + t4;
                u32x2 vlo[2][4], vhh[2][4];
#pragma unroll
                for (int k2 = 0; k2 < 2; ++k2)
#pragma unroll
                    for (int dt = 0; dt < 4; ++dt) { const LAS unsigned char* vp = VTB + (32 * dt + l31) * MA_VS + (32 * t4 + 16 * k2 + 4 * hi) * 2;
                        vlo[k2][dt] = *(const LAS u32x2*)vp; vhh[k2][dt] = *(const LAS u32x2*)(vp + 16); }
                SB();
#pragma unroll
                for (int k2 = 0; k2 < 2; ++k2) { const bf16x8 yp = mk8(Pk[T][4 * k2], Pk[T][4 * k2 + 1], Pk[T][4 * k2 + 2], Pk[T][4 * k2 + 3]);
#pragma unroll
                    for (int dt = 0; dt < 4; ++dt) O[dt] = mfma32(mk8(vlo[k2][dt].x, vlo[k2][dt].y, vhh[k2][dt].x, vhh[k2][dt].y), yp, O[dt]); }
                SB(); }
            lds_barrier();
            if (kb2 == 1 && (!smp || (w == 0 && l31 < 16))) {
#pragma unroll
                for (int dt = 0; dt < 4; ++dt)
#pragma unroll
                    for (int rg = 0; rg < 4; ++rg) *(u32x2*)(OB + (size_t)qrow * DM + h * 256 + 128 * dh + 32 * dt + 8 * rg + 4 * hi) =
                        (u32x2){pkbf(O[dt][4 * rg] * inv, O[dt][4 * rg + 1] * inv), pkbf(O[dt][4 * rg + 2] * inv, O[dt][4 * rg + 3] * inv)};
            }
        }
        if (!has_next) break;
        u = un; qrow = nqrow; memrow0 = nm0; h = nh; smp = nsmp;
    }
#undef MA_UNIT
#undef MA_LOADK
#undef MA_LOADV
}

template <int NB, int K, class Epi>
__device__ __forceinline__ void skinny_phase(const bf16_t* __restrict__ A, const bf16_t* __restrict__ Bt, int ntasks, LAS unsigned char* lds, int bx, int G, const Epi& E) {
    const int tid = fresh_tid(), lane = tid & 63, w = __builtin_amdgcn_readfirstlane(tid >> 6), fr = lane & 15, fq = lane >> 4;
    constexpr int kw = K / 8, NS = kw / 32;
    const int k0 = w * kw;
    LAS f32x4* red = (LAS f32x4*)lds;
    for (int t = bx; t < 4 * ntasks; t += G) {
        const int ct = t >> 2, rg = t & 3;
        f32x4 fin[NB];
#pragma unroll
        for (int nb = 0; nb < NB; ++nb) {
            const bf16_t* bp = Bt + (size_t)(E.brow(ct, nb) + fr) * K + k0 + 8 * fq;
            const bf16_t* ap = A + (size_t)(32 * rg + fr) * K + k0 + 8 * fq;
            bf16x8 xb[NS], ya[NS][2];
#pragma unroll
            for (int ks = 0; ks < NS; ++ks) { xb[ks] = *(const bf16x8*)(bp + 32 * ks); ya[ks][0] = *(const bf16x8*)(ap + 32 * ks); ya[ks][1] = *(const bf16x8*)(ap + (size_t)16 * K + 32 * ks); }
            f32x4 acc[2]; acc[0] = (f32x4){0.f, 0.f, 0.f, 0.f}; acc[1] = acc[0];
#pragma unroll
            for (int ks = 0; ks < NS; ++ks) { acc[0] = mfma16(xb[ks], ya[ks][0], acc[0]); acc[1] = mfma16(xb[ks], ya[ks][1], acc[1]); }
            red[(w * 2 + 0) * 64 + lane] = acc[0]; red[(w * 2 + 1) * 64 + lane] = acc[1];
            lds_barrier();
            f32x4 sum = (f32x4){0.f, 0.f, 0.f, 0.f};
            if (w < 2) {
#pragma unroll
                for (int ww = 0; ww < 8; ++ww) sum += red[(ww * 2 + w) * 64 + lane]; }
            fin[nb] = sum;
            lds_barrier();
        }
        if (w < 2) E.tile(ct, 32 * rg + 16 * w + fr, 4 * fq, fin);
    }
}
struct SkZ {
    bf16_t* Z; float* out;
    __device__ __forceinline__ int brow(int t, int) const { return 16 * t; }
    __device__ __forceinline__ void tile(int t, int m, int c4, const f32x4 (&v)[1]) const { const int n = 16 * t + c4; f32x4 x = v[0];
        if (n < 512 || (n >= ZC_HG && n < ZC_AQ)) {
#pragma unroll
            for (int e = 0; e < 4; ++e) x[e] = pg8::silu_f(x[e]); }
        *(u32x2*)(Z + (size_t)(MP + m) * INC + n) = (u32x2){pkbf(x[0], x[1]), pkbf(x[2], x[3])};
        if (n >= ZC_AK) { float* d = out + (n >= ZC_AV ? OFF_VS + (size_t)m * 128 + (n - ZC_AV) : OFF_KS + (size_t)m * 128 + (n - ZC_AK)); *(f32x4*)d = x; } }
};
struct SkRes {
    bf16_t* XPRE; const bf16_t* XB; const float* xs;
    __device__ __forceinline__ int brow(int t, int) const { return 16 * t; }
    __device__ __forceinline__ void tile(int t, int m, int c4, const f32x4 (&v)[1]) const { const int n = 16 * t + c4; f32x4 r;
        if (xs) r = *(const f32x4*)(xs + (size_t)m * DM + n);
        else { const u32x2 q = *(const u32x2*)(XB + (size_t)(MP + m) * DM + n); r = (f32x4){bflo(q.x), bfhi(q.x), bflo(q.y), bfhi(q.y)}; }
        const f32x4 y = r * ALPHA + v[0];
        st8_wt(XPRE + (size_t)(MP + m) * DM + n, (u32x2){pkbf(y[0], y[1]), pkbf(y[2], y[3])}); }
};
struct SkQ {
    bf16_t* O; float scale;
    __device__ __forceinline__ int brow(int t, int) const { return 16 * t; }
    __device__ __forceinline__ void tile(int t, int m, int c4, const f32x4 (&v)[1]) const { const f32x4 y = v[0] * scale;
        *(u32x2*)(O + (size_t)(MP + m) * DM + 16 * t + c4) = (u32x2){pkbf(y[0], y[1]), pkbf(y[2], y[3])}; }
};
struct SkSwiglu {
    bf16_t* H;
    __device__ __forceinline__ int brow(int t, int nb) const { const int j = 16 * t; return 256 * (j >> 7) + (j & 127) + 128 * nb; }
    __device__ __forceinline__ void tile(int t, int m, int c4, const f32x4 (&v)[2]) const {
        *(u32x2*)(H + (size_t)(MP + m) * DFF + 16 * t + c4) = (u32x2){pkbf(pg8::silu_f(v[0][0]) * v[1][0], pg8::silu_f(v[0][1]) * v[1][1]), pkbf(pg8::silu_f(v[0][2]) * v[1][2], pg8::silu_f(v[0][3]) * v[1][3])}; }
};

template <int MODE>
__device__ __forceinline__ void skinny_batch_phase(const bf16_t* __restrict__ A, const bf16_t* __restrict__ Bt, bf16_t* __restrict__ Pst, float* __restrict__ LSUM, bf16_t* __restrict__ XPRE, const bf16_t* __restrict__ XB,
                                                   LAS unsigned char* lds, int bx, int G) {
    const int tid = fresh_tid(), lane = tid & 63, w = __builtin_amdgcn_readfirstlane(tid >> 6), fr = lane & 15, fq = lane >> 4;
    LAS f32x4* red = (LAS f32x4*)lds;
    for (int t = bx; t < SBATCH * 64; t += G) {
        const int bs = t >> 6, ct = t & 63;
        const bf16_t* bp = Bt + ((size_t)(NBATCH + bs) * DM + 16 * ct + fr) * DM + 128 * w + 8 * fq;
        const bf16_t* ap = A + (size_t)(MP + bs * SSEQ + fr) * DM + 128 * w + 8 * fq;
        bf16x8 xb[4], ya[4];
#pragma unroll
        for (int ks = 0; ks < 4; ++ks) { xb[ks] = *(const bf16x8*)(bp + 32 * ks); ya[ks] = *(const bf16x8*)(ap + 32 * ks); }
        f32x4 acc = (f32x4){0.f, 0.f, 0.f, 0.f};
#pragma unroll
        for (int ks = 0; ks < 4; ++ks) acc = mfma16(xb[ks], ya[ks], acc);
        if (MODE == 1) acc = acc * (1.0f / LSUM[(bs * SSEQ + fr) * 4 + (w >> 1)]);
        red[w * 64 + lane] = acc;
        lds_barrier();
        if (w == 0) { f32x4 v = (f32x4){0.f, 0.f, 0.f, 0.f};
#pragma unroll
            for (int ww = 0; ww < 8; ++ww) v += red[ww * 64 + lane];
            const size_t row = (size_t)(MP + bs * SSEQ + fr); const int n = 16 * ct + 4 * fq;
            if (MODE == 0) {
#pragma unroll
                for (int e = 0; e < 4; ++e) v[e] = __expf(v[e]);
                *(u32x2*)(Pst + row * DM + n) = (u32x2){pkbf(v[0], v[1]), pkbf(v[2], v[3])};
                float sm = (v[0] + v[1]) + (v[2] + v[3]); sm += __shfl_xor(sm, 16); sm += __shfl_xor(sm, 32);
                if (fq == 0) atomicAdd(LSUM + (bs * SSEQ + fr) * 4 + (ct >> 4), sm);
            } else { const u32x2 q = *(const u32x2*)(XB + row * DM + n); const f32x4 r = (f32x4){bflo(q.x), bfhi(q.x), bflo(q.y), bfhi(q.y)};
                const f32x4 y = r * ALPHA + v; *(u32x2*)(XPRE + row * DM + n) = (u32x2){pkbf(y[0], y[1]), pkbf(y[2], y[3])}; } }
        lds_barrier();
    }
}

template <int FINAL, int WT = 0>
__device__ __forceinline__ void ln_rows(const bf16_t* __restrict__ XPRE, bf16_t* __restrict__ XB, const float* __restrict__ g, const float* __restrict__ bt, float* __restrict__ out, int gw, int ngw, int lane, int rbeg) {
    f32x4 gv[4], bv[4];
#pragma unroll
    for (int j = 0; j < 4; ++j) { const int e = 512 * (j >> 1) + 8 * lane + 4 * (j & 1); gv[j] = *(const f32x4*)(g + e); bv[j] = *(const f32x4*)(bt + e); }
    const int nrows = MP + MS;
    for (int row = rbeg + gw; row < nrows; row += ngw) {
        const bf16_t* xr = XPRE + (size_t)row * DM + 8 * lane;
        const u32x4 w0 = *(const u32x4*)xr, w1 = *(const u32x4*)(xr + 512);
        f32x4 v[4];
        v[0] = (f32x4){bflo(w0.x), bfhi(w0.x), bflo(w0.y), bfhi(w0.y)}; v[1] = (f32x4){bflo(w0.z), bfhi(w0.z), bflo(w0.w), bfhi(w0.w)};
        v[2] = (f32x4){bflo(w1.x), bfhi(w1.x), bflo(w1.y), bfhi(w1.y)}; v[3] = (f32x4){bflo(w1.z), bfhi(w1.z), bflo(w1.w), bfhi(w1.w)};
        float s = 0.f;
#pragma unroll
        for (int j = 0; j < 4; ++j) s += (v[j][0] + v[j][1]) + (v[j][2] + v[j][3]);
#pragma unroll
        for (int o = 1; o < 64; o <<= 1) s += __shfl_xor(s, o);
        const float mean = s * (1.0f / DM); float s2 = 0.f;
#pragma unroll
        for (int j = 0; j < 4; ++j) { v[j] = v[j] - mean; s2 += (v[j][0] * v[j][0] + v[j][1] * v[j][1]) + (v[j][2] * v[j][2] + v[j][3] * v[j][3]); }
#pragma unroll
        for (int o = 1; o < 64; o <<= 1) s2 += __shfl_xor(s2, o);
        const float rstd = rsqrtf(s2 * (1.0f / DM) + LN_EPS);
#pragma unroll
        for (int j = 0; j < 4; ++j) v[j] = v[j] * rstd * gv[j] + bv[j];
        if (FINAL) { float* orow = ((row < MP) ? out + OFF_YP + (size_t)row * DM : out + OFF_YS + (size_t)(row - MP) * DM) + 8 * lane;
            *(f32x4*)orow = v[0]; *(f32x4*)(orow + 4) = v[1]; *(f32x4*)(orow + 512) = v[2]; *(f32x4*)(orow + 516) = v[3];
        } else { bf16_t* orow = XB + (size_t)row * DM + 8 * lane;
            if (WT) { st8_wt(orow, (u32x2){pkbf(v[0][0], v[0][1]), pkbf(v[0][2], v[0][3])}); st8_wt(orow + 4, (u32x2){pkbf(v[1][0], v[1][1]), pkbf(v[1][2], v[1][3])});
                      st8_wt(orow + 512, (u32x2){pkbf(v[2][0], v[2][1]), pkbf(v[2][2], v[2][3])}); st8_wt(orow + 516, (u32x2){pkbf(v[3][0], v[3][1]), pkbf(v[3][2], v[3][3])}); }
            else {
            *(u32x4*)orow = (u32x4){pkbf(v[0][0], v[0][1]), pkbf(v[0][2], v[0][3]), pkbf(v[1][0], v[1][1]), pkbf(v[1][2], v[1][3])};
            *(u32x4*)(orow + 512) = (u32x4){pkbf(v[2][0], v[2][1]), pkbf(v[2][2], v[2][3]), pkbf(v[3][0], v[3][1]), pkbf(v[3][2], v[3][3])}; } }
    }
}

#define GAS __attribute__((address_space(1)))

typedef GAS unsigned gu32;
typedef GAS unsigned long long gu64;
#define RLX_AGENT __ATOMIC_RELAXED, __HIP_MEMORY_SCOPE_AGENT
#define XB_TMO      128
#define XB_XCNT(j)  (256  + 64 * (j))
#define XB_XSUB(j)  (1280 + 64 * (j))
#define XB_XGEN(j)  (2304 + 64 * (j))
#define XB_TOP      3328
#define XB_TOPGEN   3392
#define XCD_BAR_WORDS 3456
#define XB_SPIN_CAP (1u << 18)

__device__ __forceinline__ unsigned xb_ld(unsigned* p)              { return __hip_atomic_load(p, __ATOMIC_RELAXED, __HIP_MEMORY_SCOPE_AGENT); }
__device__ __forceinline__ unsigned xb_add(unsigned* p, unsigned v) { return __hip_atomic_fetch_add(p, v, __ATOMIC_RELAXED, __HIP_MEMORY_SCOPE_AGENT); }
__device__ __forceinline__ unsigned xb_xcc_id() { return (unsigned)__builtin_amdgcn_s_getreg((3 << 11) | 20) & 0xFu; }
#define XB_SPIN(cond, bar) do { unsigned _sp = 0; while (cond) { __builtin_amdgcn_s_sleep(1); \
    if ((++_sp & 255u) == 0u) { if (xb_ld(&(bar)[XB_TMO])) break; if (_sp > XB_SPIN_CAP) { atomicAdd(&(bar)[XB_TMO], 1u); break; } } } } while (0)

struct XcdBarrier {
    unsigned* bar; unsigned x;
    volatile LAS unsigned* st;
};

__device__ __forceinline__ XcdBarrier xcd_barrier_post(unsigned* bar, volatile LAS unsigned* st) {
    XcdBarrier b; b.bar = bar; b.x = xb_xcc_id(); b.st = st;
    if (threadIdx.x == 0) (void)xb_add(&bar[XB_XCNT(b.x)], 1u);
    return b;
}
__device__ __forceinline__ void xcd_barrier_complete(unsigned* bar, unsigned x, unsigned& nloc, unsigned& nx) {
    const unsigned G = gridDim.x * gridDim.y * gridDim.z;
    unsigned sum, cnt, mine, sp = 0u;
    for (;;) {
        sum = 0u; cnt = 0u; mine = 0u;
#pragma unroll
        for (unsigned j = 0; j < 16; ++j) { const unsigned c = xb_ld(&bar[XB_XCNT(j)]); sum += c; cnt += (c > 0u) ? 1u : 0u; mine = (j == x) ? c : mine; }
        if (sum == G) break;
        __builtin_amdgcn_s_sleep(1);
        if ((++sp & 255u) == 0u) { if (xb_ld(&bar[XB_TMO])) break; if (sp > XB_SPIN_CAP) { atomicAdd(&bar[XB_TMO], 1u); break; } }
    }
    nloc = mine > 0u ? mine : 1u; nx = cnt > 0u ? cnt : 1u;
}

__device__ __forceinline__ void xcd_barrier(const XcdBarrier& b) {
    asm volatile("s_waitcnt vmcnt(0)" ::: "memory");
    __syncthreads();
    if (threadIdx.x == 0) {
        unsigned* bar = b.bar;
        __builtin_amdgcn_s_waitcnt(0);
        unsigned nloc = b.st[0], nx = b.st[1];
        if (nloc == 0u) { xcd_barrier_complete(bar, b.x, nloc, nx); b.st[0] = nloc; b.st[1] = nx; }
        const unsigned old = xb_add(&bar[XB_XSUB(b.x)], 1u);
        const unsigned gen = old / nloc;
        if (old + 1u == (gen + 1u) * nloc) {
            __builtin_amdgcn_fence(__ATOMIC_RELEASE, "agent");
            asm volatile("s_waitcnt vmcnt(0)" ::: "memory");
            const unsigned og = xb_add(&bar[XB_TOP], 1u);
            const unsigned tg = og / nx;
            if (og + 1u == (tg + 1u) * nx) xb_add(&bar[XB_TOPGEN], 1u);
            else XB_SPIN(xb_ld(&bar[XB_TOPGEN]) == tg, bar);
            __builtin_amdgcn_fence(__ATOMIC_ACQUIRE, "agent");
            xb_add(&bar[XB_XGEN(b.x)], 1u);
            asm volatile("s_waitcnt vmcnt(0)" ::: "memory");
        } else {
            XB_SPIN(xb_ld(&bar[XB_XGEN(b.x)]) == gen, bar);
            __builtin_amdgcn_fence(__ATOMIC_ACQUIRE, "agent");
            asm volatile("s_waitcnt vmcnt(0)" ::: "memory");
        }
    }
    __syncthreads();
}

__device__ __forceinline__ void flag_arrive(unsigned* cnt) { __threadfence(); __syncthreads(); if (threadIdx.x == 0) __hip_atomic_fetch_add(cnt, 1u, __ATOMIC_RELAXED, __HIP_MEMORY_SCOPE_AGENT); }
__device__ __forceinline__ void flag_arrive_wt(unsigned* cnt) { asm volatile("s_waitcnt vmcnt(0)" ::: "memory"); __syncthreads(); if (threadIdx.x == 0) __hip_atomic_fetch_add(cnt, 1u, __ATOMIC_RELAXED, __HIP_MEMORY_SCOPE_AGENT); }
__device__ __forceinline__ void flag_wait(unsigned* cnt, unsigned target) {
    if (threadIdx.x == 0) {
        for (unsigned sp = 0; sp < (1u << 22); ++sp) { if (__hip_atomic_load(cnt, __ATOMIC_RELAXED, __HIP_MEMORY_SCOPE_AGENT) >= target) break; __builtin_amdgcn_s_sleep(2); }
        __builtin_amdgcn_fence(__ATOMIC_ACQUIRE, "agent"); asm volatile("s_waitcnt vmcnt(0)" ::: "memory"); }
    __syncthreads();
}
#ifndef REP_G
#define REP_G 1
#endif
#ifndef REP_L
#define REP_L 1
#endif
constexpr int LDS_XL = 131072 + 256;
#ifndef FUSE_LN
#define FUSE_LN 1
#endif
constexpr int LDS_BYTES = 131072 + 256 + 10240 + 256;
constexpr int CW_BAR = 1024;
constexpr bool kALIGN = true, kSP2 = true;
__global__ void __launch_bounds__(512, 2) fwd_kernel(Params P) {
    extern __shared__ __attribute__((aligned(16))) unsigned char lds_raw[];
    LAS unsigned char* lds = (LAS unsigned char*)lds_raw;
    cg::grid_group grid = cg::this_grid();
    const int G = gridDim.x, bx = blockIdx.x;
    const int ngw = G * 8;
    const size_t nt = (size_t)G * 512;
#define FRESH_IDS() const int tid = fresh_tid(), lane = tid & 63, wave = __builtin_amdgcn_readfirstlane(tid >> 6), gw = bx * 8 + wave; const size_t gt = (size_t)bx * 512 + tid; (void)lane; (void)gw; (void)gt
    unsigned char* ws = P.ws; float* out = P.out;
    unsigned* ctl = (unsigned*)(ws + WS_CTL);
    bf16_t* WinT = (bf16_t*)(ws + WS_WIN); bf16_t* WoutT = (bf16_t*)(ws + WS_WOUT); bf16_t* WqN = (bf16_t*)(ws + WS_WQ); bf16_t* WkvT = (bf16_t*)(ws + WS_WKV);
    bf16_t* WoT = (bf16_t*)(ws + WS_WO); bf16_t* Wf1T = (bf16_t*)(ws + WS_WF1); bf16_t* Wf2T = (bf16_t*)(ws + WS_WF2);
    bf16_t* XB = (bf16_t*)(ws + WS_XB); bf16_t* Z = (bf16_t*)(ws + WS_Z); bf16_t* MIX = (bf16_t*)(ws + WS_MIX); bf16_t* XPRE = (bf16_t*)(ws + WS_XPRE);
    bf16_t* WPT = (bf16_t*)(ws + WS_WPT); bf16_t* VPT = (bf16_t*)(ws + WS_VPT); float* LSUM = (float*)(ws + WS_CTL + 32768);
    bf16_t* MEMB = (bf16_t*)(ws + WS_MEMB); bf16_t* MKB = (bf16_t*)(ws + WS_MKB); bf16_t* MVB = (bf16_t*)(ws + WS_MVB);
    const float* x_prompt = P.in[0]; const float* x_sample = P.in[1];

    if (threadIdx.x < 64) ((LAS unsigned*)(lds + 131072))[threadIdx.x] = 0u;
    __syncthreads();
    if (P.ws == nullptr) grid.sync();
    const XcdBarrier bar = xcd_barrier_post((unsigned*)(P.ws + WS_CTL) + CW_BAR, (volatile LAS unsigned*)(lds + 131072 + 64));
    for (int rl = 0; rl < REP_L; ++rl) {
        FRESH_IDS();
        for (size_t i = gt; i < (size_t)3 * MP * 4 / 2; i += nt) ((u32x4*)(ws + WS_XCH))[i] = (u32x4){~0u, ~0u, ~0u, ~0u};
        LAS float* scr = (LAS float*)(lds + wave * 16384);
        constexpr int I_IN = 16 * 88, I_SQ = 16 * 32, I_KV = 16 * 64, I_F1 = 16 * 176, I_F2 = 44 * 32;
        constexpr int NIT = I_IN + 2 * I_SQ + I_KV + I_F1 + I_F2;
        for (int it = gw; it < NIT; it += ngw) { int r = it;
            if (r < I_IN) { transpose_item(P.in[8], DM, INC, WinT, scr, r, lane, 0); continue; } r -= I_IN;
            if (r < I_SQ) { transpose_item(P.in[12], DM, DM, WoutT, scr, r, lane, 0); continue; } r -= I_SQ;
            if (r < I_KV) { transpose_item(P.in[14], DM, 2 * DM, WkvT, scr, r, lane, 0); continue; } r -= I_KV;
            if (r < I_SQ) { transpose_item(P.in[15], DM, DM, WoT, scr, r, lane, 0); continue; } r -= I_SQ;
            if (r < I_F1) { transpose_item(P.in[16], DM, 2 * DFF, Wf1T, scr, r, lane, 1); continue; } r -= I_F1;
            transpose_item(P.in[17], DFF, DM, Wf2T, scr, r, lane, 0);
        }
        cvt_copy(x_prompt, XB, (size_t)MP * DM / 8, gt, nt);
        cvt_copy(x_sample, XB + (size_t)MP * DM, (size_t)MS * DM / 8, gt, nt);
        zero16(XB + (size_t)(MP + MS) * DM, (size_t)(MT - MP - MS) * DM * 2 / 16, gt, nt);
        zero16(MIX + (size_t)(MP + MS) * DM, (size_t)(MT - MP - MS) * DM * 2 / 16, gt, nt);
        cvt_copy(P.in[13], WqN, (size_t)DM * DM / 8, gt, nt);
        cvt_copy(P.in[7], MEMB, (size_t)MEMROWS_P * DM / 8, gt, nt);
        cvt_copy(P.in[5], MKB + (size_t)MEMROWS_P * DM, (size_t)SBATCH * MEMT * DM / 8, gt, nt);
        cvt_copy(P.in[6], MVB + (size_t)MEMROWS_P * DM, (size_t)SBATCH * MEMT * DM / 8, gt, nt);
    }
    xcd_barrier(bar);
    for (int rg = 0; rg < REP_G; ++rg) {
        { pg8::Gemm g{XB, WinT, MP, INC, DM, DM, DM, 0}; pg8::StaticOrder S; S.init(MP, INC, G, bx); pg8::EpiZ E{Z, out};
          pg8::gemm_phase<pg8::EpiZ, pg8::StaticOrder, kALIGN, kSP2>(lds, g, S, E); }
        { SkZ E{Z, out}; skinny_phase<1, DM>(XB + (size_t)MP * DM, WinT, INC / 16, lds, bx, G, E); }
    }
    xcd_barrier(bar);
#ifndef REP_P2
#define REP_P2 1
#endif
#ifndef REP_P6
#define REP_P6 1
#endif
    for (int rep = 0; rep < REP_P2; ++rep) {
        if (rep > 0) { xcd_barrier(bar); if (bx == 0 && threadIdx.x == 0) __hip_atomic_store(ctl, 0u, __ATOMIC_RELAXED, __HIP_MEMORY_SCOPE_AGENT); xcd_barrier(bar); }
        if (bx < 128) { const int b = bx >> 2, h = bx & 3;
            hgrn_item<64, SEQ / 64, false>(Z, MIX, P.in[9], P.in[10], nullptr, out + OFF_SP + (size_t)(b * 4 + h) * 16384, lds, b * SEQ, h);
        } else if (bx < 160) { const int b = (bx - 128) >> 2, h = (bx - 128) & 3;
            hgrn_item<SSEQ, 1, true>(Z, MIX, P.in[9], P.in[10], P.in[4] + (size_t)(b * 4 + h) * 16384, out + OFF_SS + (size_t)(b * 4 + h) * 16384, lds, MP + b * SSEQ, h);
        }
        if (bx >= 128 && rep == 0) {
            pg8::Gemm g{MEMB, WkvT, MEMROWS_P, 2 * DM, DM, DM, DM, 0}; pg8::StaticOrder S; S.init(MEMROWS_P, 2 * DM, G - 128, bx - 128); pg8::EpiKV E{MKB, MVB, out};
            pg8::gemm_phase<pg8::EpiKV, pg8::StaticOrder, kALIGN, kSP2>(lds, g, S, E);
        }
        FRESH_IDS();
        LAS int* qslot = (LAS int*)(lds + 131072);
        constexpr int NSW_P = NBATCH * 32 * 2, NSW = NSW_P + SBATCH * 2;
        for (;;) {
            __syncthreads();
            if (tid == 0) *qslot = (int)atomicAdd(ctl, 1u);
            __syncthreads();
            const int it = *qslot;
            if (it >= NSW) break;
            if (it < SBATCH * 2) swa_item<1>(Z, MIX, P.in[2], P.in[3], P.in[11], lds, it >> 1, 0, it & 1);
            else { const int ip = it - SBATCH * 2; swa_item<0>(Z, MIX, P.in[2], P.in[3], P.in[11], lds, ip >> 6, (ip >> 1) & 31, ip & 1); }
        }
    }
    xcd_barrier(bar);
    { pg8::Gemm g{MIX, WoutT, MP, DM, DM, DM, DM, 0}; pg8::StaticOrder S; S.init(MP, DM, G, bx);
      pg8::EpiResLN E{XB, x_prompt, XB, nullptr, P.in[18], P.in[19], (unsigned long long*)(ws + WS_XCH), lds + LDS_XL};
      pg8::gemm_phase<pg8::EpiResLN, pg8::StaticOrder, kALIGN, kSP2>(lds, g, S, E);
      SkRes E2{XPRE, XB, x_sample}; skinny_phase<1, DM>(MIX + (size_t)MP * DM, WoutT, DM / 16, lds, bx, G, E2); }
    int kfold = 256; asm volatile("" : "+s"(kfold));
    { pg8::Gemm g{MKB, WqN, NBT * 4 * 256, DM, kfold, DM, DM, 1}; pg8::StaticOrder S; S.init(NBT * 4 * 256, DM, G, bx); pg8::EpiQ E{WPT, 0.0625f};
      pg8::gemm_phase<pg8::EpiQ, pg8::StaticOrder, kALIGN, kSP2>(lds, g, S, E); }
    { pg8::Gemm g{WoT, MVB, NBT * 4 * 256, DM, kfold, DM, DM, 2}; pg8::StaticOrder S; S.init(NBT * 4 * 256, DM, G, bx); pg8::EpiQ E{VPT, 1.0f};
      pg8::gemm_phase<pg8::EpiQ, pg8::StaticOrder, kALIGN, kSP2>(lds, g, S, E); }
    xcd_barrier(bar);
    if (bx < 16) { { FRESH_IDS(); ln_rows<0, 1>(XPRE, XB, P.in[18], P.in[19], out, gw, ngw, lane, MP); } flag_arrive_wt(ctl + 64); }
    { pg8::Gemm g{XB, WPT, MP, DM, DM, DM, DM, 3}; pg8::StaticOrder S; S.init(MP, DM, G, bx); pg8::EpiSoftmax E{MIX, lds + LDS_XL};
      pg8::gemm_phase<pg8::EpiSoftmax, pg8::StaticOrder, kALIGN, kSP2>(lds, g, S, E);
      flag_wait(ctl + 64, 16u);
      skinny_batch_phase<0>(XB, WPT, MIX, LSUM, XPRE, XB, lds, bx, G); }
    xcd_barrier(bar);
    { pg8::Gemm g{MIX, VPT, MP, DM, DM, DM, DM, 3}; pg8::StaticOrder S; S.init(MP, DM, G, bx);
      pg8::EpiResLN E{XB, nullptr, XB, nullptr, P.in[18] + DM, P.in[19] + DM, (unsigned long long*)(ws + WS_XCH) + (size_t)MP * 4, lds + LDS_XL};
      pg8::gemm_phase<pg8::EpiResLN, pg8::StaticOrder, kALIGN, kSP2>(lds, g, S, E);
      skinny_batch_phase<1>(MIX, VPT, MIX, LSUM, XPRE, XB, lds, bx, G); }
    xcd_barrier(bar);
    if (bx < 16) { { FRESH_IDS(); ln_rows<0, 1>(XPRE, XB, P.in[18] + DM, P.in[19] + DM, out, gw, ngw, lane, MP); } flag_arrive_wt(ctl + 128); }
    for (int rg = 0; rg < REP_G; ++rg)
    { pg8::Gemm g{XB, Wf1T, MP, 2 * DFF, DM, DM, DM, 0}; pg8::StaticOrder S; S.init(MP, 2 * DFF, G, bx); pg8::EpiSwiglu E{Z};
      pg8::gemm_phase<pg8::EpiSwiglu, pg8::StaticOrder, kALIGN, kSP2>(lds, g, S, E);
      flag_wait(ctl + 128, 16u);
      SkSwiglu E2{Z}; skinny_phase<2, DM>(XB + (size_t)MP * DM, Wf1T, DFF / 16, lds, bx, G, E2); }
    xcd_barrier(bar);
    { SkRes E2{XPRE, XB, nullptr}; skinny_phase<1, DFF>(Z + (size_t)MP * DFF, Wf2T, DM / 16, lds, bx, G, E2); flag_arrive_wt(ctl + 192); }
    { pg8::Gemm g{Z, Wf2T, MP, DM, DFF, DFF, DFF, 0}; pg8::StaticOrder S; S.init(MP, DM, G, bx);
      pg8::EpiResLN E{XB, nullptr, nullptr, out + OFF_YP, P.in[18] + 2 * DM, P.in[19] + 2 * DM, (unsigned long long*)(ws + WS_XCH) + (size_t)2 * MP * 4, lds + LDS_XL};
      pg8::gemm_phase<pg8::EpiResLN, pg8::StaticOrder, kALIGN, kSP2>(lds, g, S, E); }
    if (bx < 16) { flag_wait(ctl + 192, (unsigned)G); { FRESH_IDS(); ln_rows<1>(XPRE, XB, P.in[18] + 2 * DM, P.in[19] + 2 * DM, out, gw, ngw, lane, MP); } }
}

extern "C" void kernel_launch(void* const* d_in, const int* in_sizes, int n_in, void* d_out, int out_size, void* d_ws, size_t ws_size, hipStream_t stream) {
    static int grid_blocks = 0;
    if (grid_blocks == 0) {
        if (n_in != 20 || (size_t)out_size != OUT_TOTAL || ws_size < WS_END) { fprintf(stderr, "kernel_launch: unexpected shapes (n_in %d, out %d, ws %zu; need ws >= %zu)\n", n_in, out_size, ws_size, (size_t)WS_END); grid_blocks = -1; return; }
        int dev = 0, cus = 0, per_cu = 0;
        hipGetDevice(&dev);
        hipDeviceGetAttribute(&cus, hipDeviceAttributeMultiprocessorCount, dev);
        if (hipFuncSetAttribute((const void*)fwd_kernel, hipFuncAttributeMaxDynamicSharedMemorySize, LDS_BYTES) != hipSuccess) fprintf(stderr, "kernel_launch: hipFuncSetAttribute failed\n");
        if (hipOccupancyMaxActiveBlocksPerMultiprocessor(&per_cu, (const void*)fwd_kernel, 512, LDS_BYTES) != hipSuccess || per_cu < 1) { fprintf(stderr, "kernel_launch: occupancy query gave %d\n", per_cu); per_cu = 1; }
        (void)hipGetLastError();
        grid_blocks = cus * per_cu;
        if (grid_blocks != 256) { fprintf(stderr, "kernel_launch: built for a 256-workgroup grid (256 CUs x 1), got %d: nothing launched\n", grid_blocks); grid_blocks = -1; return; }
    }
    if (grid_blocks < 0) return;
    if (hipMemsetAsync((char*)d_ws + WS_CTL, 0, 65536, stream) != hipSuccess) { fprintf(stderr, "kernel_launch: hipMemsetAsync failed\n"); return; }
    Params p{};
    for (int i = 0; i < 20; ++i) p.in[i] = (const float*)d_in[i];
    p.out = (float*)d_out; p.ws = (unsigned char*)d_ws;
    void* args[] = {&p};
    hipError_t e = hipLaunchCooperativeKernel((const void*)fwd_kernel, dim3(grid_blocks), dim3(512), args, LDS_BYTES, stream);
    if (e != hipSuccess) fprintf(stderr, "kernel_launch: cooperative launch failed: %s (grid %d)\n", hipGetErrorString(e), grid_blocks);
}
```
